# Optimizing an MI355X kernel written in HIP

```python
import jax, jax.numpy as jnp
from jax import lax
import numpy as np

D_MODEL = 2048
BATCH = 2
SEQ = 8192
DEPTH = 4

HEAD_DIM = 128
N_HEADS_TOTAL = D_MODEL // HEAD_DIM
N_HEADS_MOBA = N_HEADS_TOTAL // 4
N_HEADS_NSA = N_HEADS_TOTAL // 4
N_HEADS_FOX = N_HEADS_TOTAL - N_HEADS_MOBA - N_HEADS_NSA
MOBA_WIDTH = N_HEADS_MOBA * HEAD_DIM
NSA_WIDTH = N_HEADS_NSA * HEAD_DIM
FOX_WIDTH = N_HEADS_FOX * HEAD_DIM
MIX_WIDTH = MOBA_WIDTH + NSA_WIDTH + FOX_WIDTH
D_FF = 4 * D_MODEL

ROPE_THETA = 500000.0
ROPE_DIMS = HEAD_DIM // 4
Q_BLOCK = 128
MOBA_Q_BLOCK = 64
MOBA_BLOCK = 256
MOBA_TOPK = 3
NSA_CMP_LEN = 32
NSA_CMP_STRIDE = 16
NSA_CMP_HIDDEN = 256
NSA_SEL_BLOCK = 64
NSA_N_SEL = 16
NSA_WINDOW = 512
NSA_N_BRANCH = 3
NSA_N_KV = 6
NORM_EPS = 1e-6
NEG_INF = -1e30

PROJ_SIZES = (3 * MOBA_WIDTH, NSA_WIDTH, NSA_N_KV * HEAD_DIM,
              N_HEADS_NSA * NSA_N_BRANCH, 3 * FOX_WIDTH, N_HEADS_FOX)
PROJ_DIM = sum(PROJ_SIZES)
PROJ_OFFSETS = tuple(int(o) for o in np.cumsum(PROJ_SIZES)[:-1])

kernel_name = "hymba_moba_nsa_fox_sandwich_adaln"


def rms_norm(x, g):
    xf = x.astype(jnp.float32)
    y = xf * lax.rsqrt(jnp.mean(xf * xf, axis=-1, keepdims=True) + NORM_EPS)
    return (y * g.astype(jnp.float32)).astype(x.dtype)


def modulate(h, shift, scale):
    return h * (1.0 + scale) + shift


def rope_partial(x, positions):
    half = ROPE_DIMS // 2
    inv_freq = ROPE_THETA ** (-jnp.arange(half, dtype=jnp.float32) / half)
    ang = positions.astype(jnp.float32)[:, None, :, None] * inv_freq
    cos, sin = jnp.cos(ang), jnp.sin(ang)
    x1 = x[..., :half].astype(jnp.float32)
    x2 = x[..., half:ROPE_DIMS].astype(jnp.float32)
    rot = jnp.concatenate([x1 * cos - x2 * sin, x2 * cos + x1 * sin], axis=-1).astype(x.dtype)
    return jnp.concatenate([rot, x[..., ROPE_DIMS:]], axis=-1)


def masked_softmax(logits, mask):
    logits = jnp.where(mask, logits.astype(jnp.float32), NEG_INF)
    p = jax.nn.softmax(logits, axis=-1)
    return jnp.where(jnp.any(mask, axis=-1, keepdims=True), p, 0.0)


def to_heads(t, n):
    B, S, _ = t.shape
    return t.reshape(B, S, n, HEAD_DIM).transpose(0, 2, 1, 3)


def from_heads(t):
    B, H, S, Dh = t.shape
    return t.transpose(0, 2, 1, 3).reshape(B, S, H * Dh)


def merge_query_blocks(o):
    nq, B, H, qb, Dh = o.shape
    return jnp.moveaxis(o, 0, 2).reshape(B, H, nq * qb, Dh)


def moba_attention(q, k, v):
    B, H, S, Dh = q.shape
    scale = Dh ** -0.5
    nb = -(-S // MOBA_BLOCK)
    pad = nb * MOBA_BLOCK - S
    k_pad = jnp.pad(k, ((0, 0), (0, 0), (0, pad), (0, 0)))
    v_pad = jnp.pad(v, ((0, 0), (0, 0), (0, pad), (0, 0)))
    k_blk = k_pad.reshape(B, H, nb, MOBA_BLOCK, Dh)
    v_blk = v_pad.reshape(B, H, nb, MOBA_BLOCK, Dh)
    k_mean = jnp.mean(k_blk.astype(jnp.float32), axis=3)
    top = min(MOBA_TOPK, max(nb - 1, 1))
    n_sel = top * MOBA_BLOCK
    b_idx = jnp.arange(B)[:, None, None, None]
    h_idx = jnp.arange(H)[None, :, None, None]
    blk_ids = jnp.arange(nb)
    in_blk = jnp.arange(MOBA_BLOCK)

    def block_fn(i):
        t0 = i * MOBA_Q_BLOCK
        t = t0 + jnp.arange(MOBA_Q_BLOCK)
        own = t0 // MOBA_BLOCK
        qc = lax.dynamic_slice_in_dim(q, t0, MOBA_Q_BLOCK, axis=2)
        gate = jnp.einsum('bhqd,bhnd->bhqn', qc.astype(jnp.float32), k_mean)
        gate = jnp.where(blk_ids < own, gate, NEG_INF)
        _, idx = lax.top_k(gate, top)
        k_sel = k_blk[b_idx, h_idx, idx].reshape(B, H, MOBA_Q_BLOCK, n_sel, Dh)
        v_sel = v_blk[b_idx, h_idx, idx].reshape(B, H, MOBA_Q_BLOCK, n_sel, Dh)
        sel_mask = jnp.repeat(idx < own, MOBA_BLOCK, axis=-1)
        k_own = lax.dynamic_slice_in_dim(k_pad, own * MOBA_BLOCK, MOBA_BLOCK, axis=2)
        v_own = lax.dynamic_slice_in_dim(v_pad, own * MOBA_BLOCK, MOBA_BLOCK, axis=2)
        own_mask = (own * MOBA_BLOCK + in_blk)[None, :] <= t[:, None]
        logits = jnp.concatenate([
            jnp.einsum('bhqd,bhqkd->bhqk', qc, k_sel),
            jnp.einsum('bhqd,bhkd->bhqk', qc, k_own)], axis=-1).astype(jnp.float32) * scale
        mask = jnp.concatenate(
            [sel_mask, jnp.broadcast_to(own_mask, (B, H, MOBA_Q_BLOCK, MOBA_BLOCK))], axis=-1)
        p = masked_softmax(logits, mask)
        return (jnp.einsum('bhqk,bhqkd->bhqd', p[..., :n_sel], v_sel)
                + jnp.einsum('bhqk,bhkd->bhqd', p[..., n_sel:], v_own))

    return merge_query_blocks(lax.map(block_fn, jnp.arange(S // MOBA_Q_BLOCK)))


def compress_blocks(t, pe, w1, w2):
    B, S, Dh = t.shape
    n_cmp = (S - NSA_CMP_LEN) // NSA_CMP_STRIDE + 1
    tok = np.arange(n_cmp)[:, None] * NSA_CMP_STRIDE + np.arange(NSA_CMP_LEN)[None, :]
    blocks = t[:, tok] + pe
    flat = blocks.reshape(B, n_cmp, NSA_CMP_LEN * Dh)
    return jax.nn.gelu(flat @ w1) @ w2


def nsa_attention(q, kc, vc, ks, vs, kw, vw, gates, pe_k, pe_v, w1_k, w2_k, w1_v, w2_v):
    B, H, S, Dh = q.shape
    scale = Dh ** -0.5
    pos = jnp.arange(S)
    k_cmp = compress_blocks(kc, pe_k, w1_k, w2_k)
    v_cmp = compress_blocks(vc, pe_v, w1_v, w2_v)
    n_cmp = k_cmp.shape[1]
    cmp_end = jnp.arange(n_cmp) * NSA_CMP_STRIDE + NSA_CMP_LEN - 1
    cmp_mask = cmp_end[None, :] <= pos[:, None]
    p_cmp = masked_softmax(jnp.einsum('bhtd,bcd->bhtc', q, k_cmp) * scale, cmp_mask)
    o_cmp = jnp.einsum('bhtc,bcd->bhtd', p_cmp, v_cmp)
    n_sb = S // NSA_SEL_BLOCK
    c_first = (np.arange(n_cmp) * NSA_CMP_STRIDE) // NSA_SEL_BLOCK
    c_last = (np.arange(n_cmp) * NSA_CMP_STRIDE + NSA_CMP_LEN - 1) // NSA_SEL_BLOCK
    sb = np.arange(n_sb)
    overlap = ((sb[None, :] >= c_first[:, None]) & (sb[None, :] <= c_last[:, None])).astype(np.float32)
    imp = jnp.einsum('bhtc,cn->btn', p_cmp, jnp.asarray(overlap))
    n_sel = min(NSA_N_SEL, n_sb)
    ks_blk = ks.reshape(B, n_sb, NSA_SEL_BLOCK, Dh)
    vs_blk = vs.reshape(B, n_sb, NSA_SEL_BLOCK, Dh)
    kw_pad = jnp.pad(kw, ((0, 0), (NSA_WINDOW, 0), (0, 0)))
    vw_pad = jnp.pad(vw, ((0, 0), (NSA_WINDOW, 0), (0, 0)))
    b_idx = jnp.arange(B)[:, None, None]
    blk_ids = jnp.arange(n_sb)
    in_blk = jnp.arange(NSA_SEL_BLOCK)
    win_off = jnp.arange(NSA_WINDOW + Q_BLOCK)

    def block_fn(i):
        t0 = i * Q_BLOCK
        t = t0 + jnp.arange(Q_BLOCK)
        qc = lax.dynamic_slice_in_dim(q, t0, Q_BLOCK, axis=2)
        imp_c = lax.dynamic_slice_in_dim(imp, t0, Q_BLOCK, axis=1)
        cur = t // NSA_SEL_BLOCK
        forced = ((blk_ids[None, :] == 0) | (blk_ids[None, :] == cur[:, None])
                  | (blk_ids[None, :] == cur[:, None] - 1))
        allowed = blk_ids[None, :] <= cur[:, None]
        score = jnp.where(forced, jnp.inf, jnp.where(allowed, imp_c, -jnp.inf))
        _, idx = lax.top_k(score, n_sel)
        k_sel = ks_blk[b_idx, idx].reshape(B, Q_BLOCK, n_sel * NSA_SEL_BLOCK, Dh)
        v_sel = vs_blk[b_idx, idx].reshape(B, Q_BLOCK, n_sel * NSA_SEL_BLOCK, Dh)
        kpos = (idx[..., None] * NSA_SEL_BLOCK + in_blk).reshape(B, Q_BLOCK, -1)
        sel_mask = (kpos <= t[None, :, None])[:, None]
        p = masked_softmax(jnp.einsum('bhqd,bqkd->bhqk', qc, k_sel) * scale, sel_mask)
        o_sel = jnp.einsum('bhqk,bqkd->bhqd', p, v_sel)
        k_win = lax.dynamic_slice_in_dim(kw_pad, t0, NSA_WINDOW + Q_BLOCK, axis=1)
        v_win = lax.dynamic_slice_in_dim(vw_pad, t0, NSA_WINDOW + Q_BLOCK, axis=1)
        wpos = t0 - NSA_WINDOW + win_off
        win_mask = ((wpos[None, :] <= t[:, None]) & (wpos[None, :] > t[:, None] - NSA_WINDOW)
                    & (wpos[None, :] >= 0))
        p = masked_softmax(jnp.einsum('bhqd,bkd->bhqk', qc, k_win) * scale, win_mask)
        o_win = jnp.einsum('bhqk,bkd->bhqd', p, v_win)
        return o_sel, o_win

    o_sel, o_win = lax.map(block_fn, jnp.arange(S // Q_BLOCK))
    o_sel = merge_query_blocks(o_sel)
    o_win = merge_query_blocks(o_win)
    return gates[..., 0:1] * o_cmp + gates[..., 1:2] * o_sel + gates[..., 2:3] * o_win


def fox_attention(q, k, v, log_f):
    B, H, S, Dh = q.shape
    scale = Dh ** -0.5
    cum = jnp.cumsum(log_f, axis=-1)
    kpos = jnp.arange(S)

    def block_fn(i):
        t0 = i * Q_BLOCK
        t = t0 + jnp.arange(Q_BLOCK)
        qc = lax.dynamic_slice_in_dim(q, t0, Q_BLOCK, axis=2)
        cum_q = lax.dynamic_slice_in_dim(cum, t0, Q_BLOCK, axis=2)
        logits = (jnp.einsum('bhqd,bhkd->bhqk', qc, k).astype(jnp.float32) * scale
                  + (cum_q[..., None] - cum[:, :, None, :]))
        p = masked_softmax(logits, kpos[None, :] <= t[:, None])
        return jnp.einsum('bhqk,bhkd->bhqd', p, v)

    return merge_query_blocks(lax.map(block_fn, jnp.arange(S // Q_BLOCK)))


def hybrid_mixer(h, positions, w_in, b_forget, pe_k, pe_v, w1_k, w2_k, w1_v, w2_v, w_out):
    B, S, _ = h.shape
    proj = h @ w_in
    p_moba, p_nsa_q, p_nsa_kv, p_nsa_g, p_fox, p_fox_f = jnp.split(proj, PROJ_OFFSETS, axis=-1)
    qm, km, vm = (to_heads(t, N_HEADS_MOBA) for t in jnp.split(p_moba, 3, axis=-1))
    o_moba = moba_attention(rope_partial(qm, positions), rope_partial(km, positions), vm)
    qn = rope_partial(to_heads(p_nsa_q, N_HEADS_NSA), positions)
    kc, vc, ks, vs, kw, vw = jnp.split(p_nsa_kv, NSA_N_KV, axis=-1)
    rope_kv = lambda t: rope_partial(t[:, None], positions)[:, 0]
    gates = jax.nn.sigmoid(p_nsa_g.astype(jnp.float32)).reshape(
        B, S, N_HEADS_NSA, NSA_N_BRANCH).transpose(0, 2, 1, 3)
    o_nsa = nsa_attention(qn, rope_kv(kc), vc, rope_kv(ks), vs, rope_kv(kw), vw, gates,
                          pe_k, pe_v, w1_k, w2_k, w1_v, w2_v)
    qf, kf, vf = (to_heads(t, N_HEADS_FOX) for t in jnp.split(p_fox, 3, axis=-1))
    log_f = jax.nn.log_sigmoid((p_fox_f + b_forget).astype(jnp.float32)).transpose(0, 2, 1)
    o_fox = fox_attention(qf, kf, vf, log_f)
    o = jnp.concatenate([from_heads(o_moba), from_heads(o_nsa), from_heads(o_fox)],
                        axis=-1).astype(h.dtype)
    return o @ w_out


def sq_relu_mlp(h, w_up, w_down):
    return jnp.square(jax.nn.relu(h @ w_up)) @ w_down


def setup_inputs(seed: int = 0) -> dict:
    key = jax.random.key(seed)
    ks = jax.random.split(key, 20)
    f32 = jnp.float32

    def dense(k, shape, fan_in):
        return jax.random.normal(k, shape, f32) * fan_in ** -0.5

    def gain(k):
        return 1.0 + 0.05 * jax.random.normal(k, (DEPTH, D_MODEL), f32)

    cmp_in = NSA_CMP_LEN * HEAD_DIM
    return {
        "x": jax.random.normal(ks[0], (BATCH, SEQ, D_MODEL), f32),
        "c": jax.random.normal(ks[1], (BATCH, D_MODEL), f32),
        "positions": jnp.broadcast_to(jnp.arange(SEQ, dtype=jnp.int32), (BATCH, SEQ)),
        "w_mod": dense(ks[2], (DEPTH, D_MODEL, 6 * D_MODEL), D_MODEL),
        "b_mod": 0.02 * jax.random.normal(ks[3], (DEPTH, 6 * D_MODEL), f32),
        "g_pre_mix": gain(ks[4]),
        "g_post_mix": gain(ks[5]),
        "g_pre_mlp": gain(ks[6]),
        "g_post_mlp": gain(ks[7]),
        "w_in": dense(ks[8], (DEPTH, D_MODEL, PROJ_DIM), D_MODEL),
        "b_forget": 3.0 + 0.5 * jax.random.normal(ks[9], (DEPTH, N_HEADS_FOX), f32),
        "cmp_pe_k": 0.02 * jax.random.normal(ks[10], (DEPTH, NSA_CMP_LEN, HEAD_DIM), f32),
        "cmp_pe_v": 0.02 * jax.random.normal(ks[11], (DEPTH, NSA_CMP_LEN, HEAD_DIM), f32),
        "cmp_w1_k": dense(ks[12], (DEPTH, cmp_in, NSA_CMP_HIDDEN), cmp_in),
        "cmp_w2_k": dense(ks[13], (DEPTH, NSA_CMP_HIDDEN, HEAD_DIM), NSA_CMP_HIDDEN),
        "cmp_w1_v": dense(ks[14], (DEPTH, cmp_in, NSA_CMP_HIDDEN), cmp_in),
        "cmp_w2_v": dense(ks[15], (DEPTH, NSA_CMP_HIDDEN, HEAD_DIM), NSA_CMP_HIDDEN),
        "w_out": dense(ks[16], (DEPTH, MIX_WIDTH, D_MODEL), MIX_WIDTH),
        "w_up": dense(ks[17], (DEPTH, D_MODEL, D_FF), D_MODEL),
        "w_down": dense(ks[18], (DEPTH, D_FF, D_MODEL), D_FF),
    }


def reference(x, c, positions, w_mod, b_mod, g_pre_mix, g_post_mix, g_pre_mlp, g_post_mlp,
              w_in, b_forget, cmp_pe_k, cmp_pe_v, cmp_w1_k, cmp_w2_k, cmp_w1_v, cmp_w2_v,
              w_out, w_up, w_down):
    c_act = jax.nn.silu(c)
    for l in range(DEPTH):
        mod = (c_act @ w_mod[l] + b_mod[l])[:, None, :]
        shift_a, scale_a, gate_a, shift_m, scale_m, gate_m = jnp.split(mod, 6, axis=-1)
        h = modulate(rms_norm(x, g_pre_mix[l]), shift_a, scale_a)
        y = hybrid_mixer(h, positions, w_in[l], b_forget[l], cmp_pe_k[l], cmp_pe_v[l],
                         cmp_w1_k[l], cmp_w2_k[l], cmp_w1_v[l], cmp_w2_v[l], w_out[l])
        x = x + gate_a * rms_norm(y, g_post_mix[l])
        h = modulate(rms_norm(x, g_pre_mlp[l]), shift_m, scale_m)
        x = x + gate_m * rms_norm(sq_relu_mlp(h, w_up[l], w_down[l]), g_post_mlp[l])
    return x
```

```cpp
#include <hip/hip_runtime.h>
#include <cstdio>
#include <cstdint>

#define GAS __attribute__((address_space(1)))
#define LAS __attribute__((address_space(3)))
typedef unsigned short bf16_t;
typedef short bf16x8 __attribute__((ext_vector_type(8)));
typedef short s16x4 __attribute__((ext_vector_type(4)));
typedef float f32x2 __attribute__((ext_vector_type(2)));
typedef float f32x4 __attribute__((ext_vector_type(4)));
typedef float f32x16 __attribute__((ext_vector_type(16)));
typedef unsigned u32x2 __attribute__((ext_vector_type(2)));
typedef unsigned u32x4 __attribute__((ext_vector_type(4)));
typedef GAS unsigned gu32;

constexpr int NB = 2, SEQ = 8192, DM = 2048, NL = 4, MTOK = NB * SEQ;
constexpr int HD = 128;
constexpr int PROJ_DIM = 5908, NPROJ = 6144, PW = 5888;
constexpr int FF = 8192;
constexpr int NCMP = 511, NCMPP = 512;
constexpr float NORM_EPS = 1e-6f;
constexpr float SM_SCALE = 0.08838834764831845f;
constexpr int C_MQ = 0, C_MK = 512, C_MV = 1024, C_NQ = 1536, C_KS = 2304, C_VS = 2432, C_KW = 2560, C_VW = 2688, C_FQ = 2816, C_FK = 3840, C_FV = 4864;
constexpr int O_MOBA = 0, O_NSA = 512, O_FOX = 1024;

#define LDS_WAIT() asm volatile("s_waitcnt lgkmcnt(0)" ::: "memory")
#define VM_WAIT() asm volatile("s_waitcnt vmcnt(0)" ::: "memory")
#define RLX_AGENT __ATOMIC_RELAXED, __HIP_MEMORY_SCOPE_AGENT
__device__ __forceinline__ unsigned f2bf(float f) { unsigned u = __builtin_bit_cast(unsigned, f); return (u + 0x7fffu + ((u >> 16) & 1u)) >> 16; }
__device__ __forceinline__ unsigned pk2(float lo, float hi) { return f2bf(lo) | (f2bf(hi) << 16); }
__device__ __forceinline__ float bf2f(unsigned short b) { return __builtin_bit_cast(float, ((unsigned)b) << 16); }
__device__ __forceinline__ unsigned cvtpk(float lo, float hi) { unsigned r; asm volatile("v_cvt_pk_bf16_f32 %0, %1, %2" : "=v"(r) : "v"(lo), "v"(hi)); return r; }
__device__ __forceinline__ float wave_sum(float v) {
#pragma unroll
    for (int o = 1; o < 64; o <<= 1) v += __shfl_xor(v, o);
    return v;
}

namespace pg8 {
#define PG8_LAS __attribute__((address_space(3)))
constexpr int BM = 256, BK = 64, HALF = 128, HTB = HALF * BK * 2  , STAGE_BYTES = 8 * HTB, NXCD = 8, WGM = 4;

__host__ __device__ __forceinline__ int lds_byte(int r, int c) { const int st = (r >> 4) * 2 + (c >> 5), rr = r & 15, cc = c & 31, ob = rr * 64 + cc * 2; return st * 1024 + (ob ^ (((ob >> 9) & 1) << 5)); }
__host__ __device__ __forceinline__ void stage_rc(int b, int& R, int& C) { const int st = b / 1024, sb = b % 1024, swz = sb ^ (((sb >> 9) & 1) << 5); R = (st >> 1) * 16 + swz / 64; C = (st & 1) * 32 + (swz % 64) / 2; }
__host__ __device__ __forceinline__ int perm32(int rho) { const int n = rho >> 4, i = rho & 15; return 8 * (i >> 2) + 4 * n + (i & 3); }

struct Unit { int pm, pn, aux; };
struct Gemm { const bf16_t* A; const bf16_t* Bt; int lda, ldb, K; };

struct StaticOrder {
    int nM, nN, nwg, G, c, rep, wgm;
    __host__ __device__ void init(int M, int N, int G_, int c_, int wgm_ = WGM) { nM = M / BM; nN = N / BM; nwg = nM * nN; G = G_; c = c_; rep = 1; wgm = wgm_; }
    __host__ __device__ bool next(int i, Unit& u) const {
        const long L = (long)i * G + c; if (L >= (long)nwg * rep) return false;
        int wgid = (int)(L % nwg); { const int q = nwg / NXCD, r = nwg % NXCD, xcd = wgid % NXCD, off = wgid / NXCD; wgid = (xcd < r ? xcd * (q + 1) : r * (q + 1) + (xcd - r) * q) + off; }
        const int nig = wgm * nN, gid = wgid / nig, fm = gid * wgm, gsz = (nM - fm) < wgm ? (nM - fm) : wgm;
        u.pm = fm + ((wgid % nig) % gsz); u.pn = (wgid % nig) / gsz; u.aux = 0; return true;
    }
    __device__ __forceinline__ size_t a_off(const Unit& u, const Gemm& g) const { return (size_t)u.pm * BM * g.lda * 2; }
    __device__ __forceinline__ size_t b_off(const Unit& u, const Gemm& g) const { return (size_t)u.pn * BM * g.ldb * 2; }
    __device__ __forceinline__ void a_ready(const Unit&) const {}
    __device__ __forceinline__ void done(const Unit&) const {}
};
struct CmpOrder {
    int G, c; size_t a_sel, b_sel;
    __device__ bool next(int i, Unit& u) const { const int L = i * G + c; if (L >= 128) return false; u.pm = L & 3; u.pn = 0; u.aux = L >> 2; return true; }
    __device__ __forceinline__ size_t a_off(const Unit& u, const Gemm& g) const { return (size_t)(u.aux >> 4) * a_sel + (size_t)u.pm * BM * g.lda * 2 + (size_t)(u.aux & 15) * 256 * 2; }
    __device__ __forceinline__ size_t b_off(const Unit& u, const Gemm& g) const { return (size_t)(u.aux >> 4) * b_sel + (size_t)(u.aux & 15) * 256 * 2; }
    __device__ __forceinline__ void a_ready(const Unit&) const {}
    __device__ __forceinline__ void done(const Unit&) const {}
};

struct EpiF32 {
    static constexpr bool PERM = false, AFTER_DRAIN = false, LDS_TABLE = false;
    float* C; int ldc;
    __device__ __forceinline__ void operator()(const f32x4 (&acc)[2][2][4][2], const Unit& u, int wr, int wc, int fr, int fq) const {
        const int row0 = u.pm * BM + wr * 64 + fr, col0 = u.pn * BM + wc * 32 + 4 * fq;
#pragma unroll
        for (int ai = 0; ai < 2; ++ai)
#pragma unroll
            for (int m = 0; m < 4; ++m) { float* rowp = C + (size_t)(row0 + ai * HALF + m * 16) * ldc + col0;
#pragma unroll
                for (int bj = 0; bj < 2; ++bj)
#pragma unroll
                    for (int n = 0; n < 2; ++n) *(f32x4*)(rowp + bj * HALF + n * 16) = acc[ai][bj][m][n]; }
    }
};
struct EpiPart {
    static constexpr bool PERM = false, AFTER_DRAIN = false, LDS_TABLE = false;
    float* C;
    __device__ __forceinline__ void operator()(const f32x4 (&acc)[2][2][4][2], const Unit& u, int wr, int wc, int fr, int fq) const {
        const int row0 = u.pm * BM + wr * 64 + fr, col0 = wc * 32 + 4 * fq; float* base = C + (size_t)u.aux * 1024 * 256;
#pragma unroll
        for (int ai = 0; ai < 2; ++ai)
#pragma unroll
            for (int m = 0; m < 4; ++m) { float* rowp = base + (size_t)(row0 + ai * HALF + m * 16) * 256 + col0;
#pragma unroll
                for (int bj = 0; bj < 2; ++bj)
#pragma unroll
                    for (int n = 0; n < 2; ++n) *(f32x4*)(rowp + bj * HALF + n * 16) = acc[ai][bj][m][n]; }
    }
};
template <int ACT  > struct EpiBf16 {
    static constexpr bool PERM = true, AFTER_DRAIN = false, LDS_TABLE = false;
    bf16_t* O; int ldc;
    __device__ __forceinline__ void operator()(const f32x4 (&acc)[2][2][4][2], const Unit& u, int wr, int wc, int fr, int fq) const {
        const int row0 = u.pm * BM + wr * 64 + fr, col0 = u.pn * BM + wc * 32 + 8 * fq;
#pragma unroll
        for (int ai = 0; ai < 2; ++ai)
#pragma unroll
            for (int m = 0; m < 4; ++m) { bf16_t* rowp = O + (size_t)(row0 + ai * HALF + m * 16) * ldc + col0;
#pragma unroll
                for (int bj = 0; bj < 2; ++bj) { f32x4 v0 = acc[ai][bj][m][0], v1 = acc[ai][bj][m][1];
                    if (ACT == 1) {
#pragma unroll
                        for (int j = 0; j < 4; ++j) { const float a = fmaxf(v0[j], 0.f), b = fmaxf(v1[j], 0.f); v0[j] = a * a; v1[j] = b * b; } }
                    u32x4 w; w.x = cvtpk(v0[0], v0[1]); w.y = cvtpk(v0[2], v0[3]); w.z = cvtpk(v1[0], v1[1]); w.w = cvtpk(v1[2], v1[3]);
                    *(u32x4*)(rowp + bj * HALF) = w; } }
    }
};
struct EpiProj {
    static constexpr bool PERM = true, AFTER_DRAIN = false, LDS_TABLE = true;
    bf16_t* P; bf16_t* KC; bf16_t* VC; float* GF; const _Float16* CS; const float* bfg;
    template <int bj>
    __device__ __forceinline__ void half(const f32x4 (&acc)[2][2][4][2], const Unit& u, int wr, int wc, int fr, int fq) const {
        const int row0 = u.pm * BM + wr * 64 + fr;
        const int hb = 2 * u.pn + bj;
        if (hb >= 46) {
            if (hb == 46 && wc == 0) {
#pragma unroll
                for (int ai = 0; ai < 2; ++ai)
#pragma unroll
                    for (int m = 0; m < 4; ++m) { const int row = row0 + ai * HALF + m * 16;
#pragma unroll
                        for (int n = 0; n < 2; ++n) { f32x4 v = acc[ai][bj][m][n]; f32x4 o;
#pragma unroll
                            for (int j = 0; j < 4; ++j) { const int c = 8 * fq + 4 * n + j; float x = v[j], r;
                                if (c < 12) r = __builtin_amdgcn_rcpf(1.f + __expf(-x));
                                else if (c < 20) { x += bfg[c - 12]; r = fminf(x, 0.f) - __logf(1.f + __expf(-fabsf(x))); }
                                else r = 0.f;
                                o[j] = r; }
                            *(f32x4*)(GF + (size_t)row * 32 + 8 * fq + 4 * n) = o; } }
            }
            return;
        }
    }
    static __device__ __forceinline__ bool is_rope(int hb) { return hb < 8 || (hb >= 12 && hb < 16) || hb == 16 || hb == 18 || hb == 20; }
    static constexpr int L_TAB = 139264;
    __device__ __forceinline__ bool needs_table(const Unit& u) const { return u.pn != 23 && (is_rope(2 * u.pn) || is_rope(2 * u.pn + 1)); }
    __device__ __forceinline__ void stage_table(const Unit& u, PG8_LAS unsigned char* lds, int wid, int lane_) const {
        (void)lane_; int lane = threadIdx.x; asm volatile("" : "+v"(lane)); lane &= 63;
#pragma unroll
        for (int i = 0; i < 2; ++i) { const int s = (wid * 2 + i) * 64 + lane;
            __builtin_amdgcn_global_load_lds((const unsigned*)(CS + (size_t)(u.pm * BM + (s >> 2)) * 32 + (s & 3) * 8), (PG8_LAS unsigned*)(lds + L_TAB + (wid * 2 + i) * 1024), 16, 0, 0); }
    }
    __device__ __forceinline__ void operator()(const f32x4 (&acc)[2][2][4][2], const Unit& u, int wr, int wc, int fr, int fq, PG8_LAS unsigned char* lds) const {
        if (u.pn == 23) { half<0>(acc, u, wr, wc, fr, fq); half<1>(acc, u, wr, wc, fr, fq); return; }
        typedef _Float16 h16x8 __attribute__((ext_vector_type(8)));
        const int rl0 = wr * 64 + fr, hb0 = 2 * u.pn, col0 = wc * 32 + 8 * fq;
        const bool rp0 = (wc == 0) && is_rope(hb0), rp1 = (wc == 0) && is_rope(hb0 + 1);
        const float sg = (fq < 2) ? -1.f : 1.f;
#pragma unroll
        for (int bj = 0; bj < 2; ++bj) {
            const bool rope = bj ? rp1 : rp0; const int hb = hb0 + bj;
            bf16_t* base; int ld;
            if (hb == 16) { base = KC; ld = 128; } else if (hb == 17) { base = VC; ld = 128; } else { base = P + hb * 128; ld = PW; }
#pragma unroll
            for (int ai = 0; ai < 2; ++ai)
#pragma unroll
                for (int m = 0; m < 4; ++m) { const int rl = rl0 + ai * HALF + m * 16, row = u.pm * BM + rl;
                    f32x4 v0 = acc[ai][bj][m][0], v1 = acc[ai][bj][m][1];
                    if (rope) {
                        f32x4 o0, o1;
#pragma unroll
                        for (int j = 0; j < 4; ++j) {
                            const auto s0_ = __builtin_amdgcn_permlane32_swap(__float_as_uint(v0[j]), __float_as_uint(v0[j]), false, false), s1_ = __builtin_amdgcn_permlane32_swap(__float_as_uint(v1[j]), __float_as_uint(v1[j]), false, false);
                            o0[j] = __uint_as_float(fq < 2 ? s0_[1] : s0_[0]); o1[j] = __uint_as_float(fq < 2 ? s1_[1] : s1_[0]); }
                        const h16x8 cc = *(const PG8_LAS h16x8*)(lds + L_TAB + rl * 64 + (fq & 1) * 16), ss = *(const PG8_LAS h16x8*)(lds + L_TAB + rl * 64 + 32 + (fq & 1) * 16);
                        const f32x4 c0 = {(float)cc[0], (float)cc[1], (float)cc[2], (float)cc[3]}, c1 = {(float)cc[4], (float)cc[5], (float)cc[6], (float)cc[7]};
                        const f32x4 s0 = {(float)ss[0], (float)ss[1], (float)ss[2], (float)ss[3]}, s1 = {(float)ss[4], (float)ss[5], (float)ss[6], (float)ss[7]};
                        v0 = v0 * c0 + sg * (o0 * s0); v1 = v1 * c1 + sg * (o1 * s1);
                    }
                    u32x4 w; w.x = cvtpk(v0[0], v0[1]); w.y = cvtpk(v0[2], v0[3]); w.z = cvtpk(v1[0], v1[1]); w.w = cvtpk(v1[2], v1[3]);
                    *(u32x4*)(base + (size_t)row * ld + col0) = w; }
        }
    }
};

template <class Epi, class Sched, bool ALIGN_EPI = false, bool SP2 = false>
__device__ __forceinline__ void gemm_phase(PG8_LAS unsigned char* lds, const Gemm g, const Sched& S, const Epi& E) {
    int tid_ = threadIdx.x; asm volatile("" : "+v"(tid_));
    const int tid = tid_, wid = __builtin_amdgcn_readfirstlane(tid >> 6), lane = tid & 63, wr = wid >> 2, wc = wid & 3, fr = lane & 15, fq = lane >> 4;
    const int K = g.K, nt = K / BK, lda = g.lda, ldb = g.ldb;
    unsigned voffA[2], voffB[2];
#pragma unroll
    for (int i = 0; i < 2; ++i) { int R, C; stage_rc(tid * 16 + i * 8192, R, C); const int Rb = Epi::PERM ? ((R & ~31) + perm32(R & 31)) : R;
        voffA[i] = (unsigned)(R * lda + C) * 2u; voffB[i] = (unsigned)(Rb * ldb + C) * 2u; }
    const size_t kstep = (size_t)(BK * 2);
    const size_t hstepA = (size_t)HALF * lda * 2, hstepB = (size_t)HALF * ldb * 2;
        const unsigned ldsw = (unsigned)wid * 1024u;
    const int aoff = lds_byte(wr * 64 + fr, fq * 8), boff = lds_byte(wc * 32 + fr, fq * 8);
#define PG8_SA(b, h) (((b) * 2 + (h)) * HTB)
#define PG8_SB(b, h) ((4 + (b) * 2 + (h)) * HTB)
#define PG8_STAGE(bufoff, gbase, voff) do { _Pragma("unroll") for (int _i = 0; _i < 2; ++_i) \
        __builtin_amdgcn_global_load_lds((const unsigned*)((const char*)(gbase) + (voff)[_i]), (PG8_LAS unsigned*)(lds + (bufoff) + ldsw + _i * 8192), 16, 0, 0); } while (0)
#define PG8_LDA(dst, b, h) do { _Pragma("unroll") for (int m = 0; m < 4; ++m) _Pragma("unroll") for (int k = 0; k < 2; ++k) dst[m][k] = *(const PG8_LAS bf16x8*)(lds + PG8_SA(b, h) + aoff + m * 2048 + k * 1024); } while (0)
#define PG8_LDB(dst, b, h) do { _Pragma("unroll") for (int n = 0; n < 2; ++n) _Pragma("unroll") for (int k = 0; k < 2; ++k) dst[n][k] = *(const PG8_LAS bf16x8*)(lds + PG8_SB(b, h) + boff + n * 2048 + k * 1024); } while (0)
#define PG8_MMA(ai, bj, At, Bt) do { __builtin_amdgcn_s_setprio(1); _Pragma("unroll") for (int m = 0; m < 4; ++m) _Pragma("unroll") for (int n = 0; n < 2; ++n) _Pragma("unroll") for (int k = 0; k < 2; ++k) \
        acc[ai][bj][m][n] = __builtin_amdgcn_mfma_f32_16x16x32_bf16(Bt[n][k], At[m][k], acc[ai][bj][m][n], 0, 0, 0); __builtin_amdgcn_s_setprio(0); } while (0)
#define PG8_WAIT_V(n) asm volatile("s_waitcnt vmcnt(" #n ")" ::: "memory")
#define PG8_WAIT_L(n) asm volatile("s_waitcnt lgkmcnt(" #n ")" ::: "memory")
#define PG8_BAR __builtin_amdgcn_s_barrier()
#define PG8_SCHED __builtin_amdgcn_sched_barrier(0)
    Unit cur, nxt; int ui = 0;
    if (!S.next(0, cur)) return;
    f32x4 acc[2][2][4][2];
#pragma unroll
    for (int a = 0; a < 2; ++a)
#pragma unroll
        for (int b = 0; b < 2; ++b)
#pragma unroll
            for (int m = 0; m < 4; ++m)
#pragma unroll
                for (int n = 0; n < 2; ++n) acc[a][b][m][n] = (f32x4){0.f, 0.f, 0.f, 0.f};
    bf16x8 At[4][2], B0[2][2], B1[2][2];
    const char* cA = (const char*)g.A + S.a_off(cur, g); const char* cB = (const char*)g.Bt + S.b_off(cur, g);
    S.a_ready(cur);
    if constexpr (Epi::LDS_TABLE) { if (E.needs_table(cur)) E.stage_table(cur, lds, wid, lane); }
    if constexpr (SP2) {
        PG8_STAGE(PG8_SB(0, 0), cB, voffB); PG8_STAGE(PG8_SB(0, 1), cB + hstepB, voffB); PG8_STAGE(PG8_SA(0, 0), cA, voffA); PG8_STAGE(PG8_SA(0, 1), cA + hstepA, voffA);
        if (wr == 1) PG8_BAR;
        PG8_WAIT_V(2); PG8_BAR;
        PG8_STAGE(PG8_SB(1, 0), cB + kstep, voffB); PG8_STAGE(PG8_SA(1, 0), cA + kstep, voffA); PG8_STAGE(PG8_SB(1, 1), cB + hstepB + kstep, voffB);
        PG8_WAIT_V(6); PG8_BAR;
    } else {
        PG8_STAGE(PG8_SB(0, 0), cB, voffB); PG8_STAGE(PG8_SA(0, 0), cA, voffA); PG8_STAGE(PG8_SB(0, 1), cB + hstepB, voffB); PG8_STAGE(PG8_SA(0, 1), cA + hstepA, voffA);
        if (wr == 1) PG8_BAR;
        PG8_WAIT_V(4); PG8_BAR;
        PG8_STAGE(PG8_SB(1, 0), cB + kstep, voffB); PG8_STAGE(PG8_SA(1, 0), cA + kstep, voffA); PG8_STAGE(PG8_SB(1, 1), cB + hstepB + kstep, voffB);
        PG8_WAIT_V(6); PG8_BAR;
    }
    for (;;) {
        const bool has_next = S.next(ui + 1, nxt);
        const char* nA = has_next ? (const char*)g.A + S.a_off(nxt, g) : cA; const char* nB = has_next ? (const char*)g.Bt + S.b_off(nxt, g) : cB;
        for (int t = 0; t < nt; t += 2) {
            const bool last = (t == nt - 2);
            const char* a1 = cA + (size_t)(t + 1) * kstep;
            const char* a2 = last ? nA : cA + (size_t)(t + 2) * kstep; const char* b2 = last ? nB : cB + (size_t)(t + 2) * kstep;
            const char* a3 = a2 + kstep; const char* b3 = b2 + kstep;
            if (last && has_next) S.a_ready(nxt);
            if constexpr (SP2) {
            PG8_LDB(B0, 0, 0); PG8_LDB(B1, 0, 1); PG8_SCHED; PG8_LDA(At, 0, 0); PG8_STAGE(PG8_SA(1, 1), a1 + hstepA, voffA);
            PG8_WAIT_V(8); PG8_WAIT_L(0); PG8_BAR; PG8_MMA(0, 0, At, B0); PG8_MMA(0, 1, At, B1); PG8_BAR; PG8_SCHED;
            PG8_LDA(At, 0, 1); PG8_STAGE(PG8_SB(0, 0), b2, voffB); PG8_STAGE(PG8_SB(0, 1), b2 + hstepB, voffB); PG8_STAGE(PG8_SA(0, 0), a2, voffA);
            PG8_WAIT_V(8); PG8_WAIT_L(0); PG8_BAR; PG8_MMA(1, 0, At, B0); PG8_MMA(1, 1, At, B1); PG8_BAR; PG8_SCHED;
            PG8_LDB(B0, 1, 0); PG8_LDB(B1, 1, 1); PG8_SCHED; PG8_LDA(At, 1, 0); PG8_STAGE(PG8_SA(0, 1), a2 + hstepA, voffA);
            PG8_WAIT_V(8); PG8_WAIT_L(0); PG8_BAR; PG8_MMA(0, 0, At, B0); PG8_MMA(0, 1, At, B1); PG8_BAR; PG8_SCHED;
            PG8_LDA(At, 1, 1); PG8_STAGE(PG8_SB(1, 0), b3, voffB); PG8_STAGE(PG8_SB(1, 1), b3 + hstepB, voffB); PG8_STAGE(PG8_SA(1, 0), a3, voffA);
            PG8_WAIT_V(8); PG8_WAIT_L(0); PG8_BAR; PG8_MMA(1, 0, At, B0); PG8_MMA(1, 1, At, B1); PG8_BAR; PG8_SCHED;
            } else {
            PG8_LDB(B0, 0, 0); PG8_SCHED; PG8_LDA(At, 0, 0); PG8_STAGE(PG8_SA(1, 1), a1 + hstepA, voffA);
            PG8_WAIT_L(8); PG8_BAR; PG8_WAIT_L(0); PG8_MMA(0, 0, At, B0); PG8_BAR; PG8_SCHED;
            PG8_LDB(B1, 0, 1); PG8_STAGE(PG8_SB(0, 0), b2, voffB);
            PG8_BAR; PG8_WAIT_L(0); PG8_MMA(0, 1, At, B1); PG8_BAR;
            PG8_LDA(At, 0, 1); PG8_STAGE(PG8_SA(0, 0), a2, voffA);
            PG8_BAR; PG8_WAIT_L(0); PG8_MMA(1, 0, At, B0); PG8_BAR; PG8_SCHED;
            PG8_STAGE(PG8_SB(0, 1), b2 + hstepB, voffB);
            PG8_WAIT_V(6); PG8_BAR; PG8_MMA(1, 1, At, B1); PG8_BAR;
            PG8_LDB(B0, 1, 0); PG8_SCHED; PG8_LDA(At, 1, 0); PG8_STAGE(PG8_SA(0, 1), a2 + hstepA, voffA);
            PG8_WAIT_L(8); PG8_BAR; PG8_WAIT_L(0); PG8_MMA(0, 0, At, B0); PG8_BAR; PG8_SCHED;
            PG8_LDB(B1, 1, 1); PG8_STAGE(PG8_SB(1, 0), b3, voffB);
            PG8_BAR; PG8_WAIT_L(0); PG8_MMA(0, 1, At, B1); PG8_BAR;
            PG8_LDA(At, 1, 1); PG8_STAGE(PG8_SA(1, 0), a3, voffA);
            PG8_BAR; PG8_WAIT_L(0); PG8_MMA(1, 0, At, B0); PG8_BAR; PG8_SCHED;
            PG8_STAGE(PG8_SB(1, 1), b3 + hstepB, voffB);
            PG8_WAIT_V(6); PG8_BAR; PG8_MMA(1, 1, At, B1); PG8_BAR;
            }
        }
        if constexpr (ALIGN_EPI) { if (wr == 0) PG8_BAR; }
        if constexpr (Epi::LDS_TABLE) { E(acc, cur, wr, wc, fr, fq, lds); S.done(cur); }
        else if constexpr (!Epi::AFTER_DRAIN) { E(acc, cur, wr, wc, fr, fq); S.done(cur); }
        if (!has_next) break;
#pragma unroll
        for (int a = 0; a < 2; ++a)
#pragma unroll
            for (int b = 0; b < 2; ++b)
#pragma unroll
                for (int m = 0; m < 4; ++m)
#pragma unroll
                    for (int n = 0; n < 2; ++n) acc[a][b][m][n] = (f32x4){0.f, 0.f, 0.f, 0.f};
        if constexpr (Epi::LDS_TABLE) { if (E.needs_table(nxt)) { PG8_BAR; E.stage_table(nxt, lds, wid, lane); } }
        cur = nxt; cA = nA; cB = nB; ++ui;
        if constexpr (ALIGN_EPI) { if (wr == 1) PG8_BAR; }
    }
    PG8_WAIT_V(0);
    if constexpr (!ALIGN_EPI) { if (wr == 0) PG8_BAR; }
    PG8_BAR;
    if constexpr (Epi::AFTER_DRAIN) { E.fused(acc, cur, wr, wc, fr, fq, lds, wid, lane); S.done(cur); }
#undef PG8_SA
#undef PG8_SB
#undef PG8_STAGE
#undef PG8_LDA
#undef PG8_LDB
#undef PG8_MMA
#undef PG8_WAIT_V
#undef PG8_WAIT_L
#undef PG8_BAR
#undef PG8_SCHED
}

}
#define XB_TMO      128
#define XB_XCNT(j)  (256  + 64 * (j))
#define XB_XSUB(j)  (1280 + 64 * (j))
#define XB_XGEN(j)  (2304 + 64 * (j))
#define XB_TOP      3328
#define XB_TOPGEN   3392
#define XCD_BAR_WORDS 3456
#define XB_SPIN_CAP (1u << 18)

__device__ __forceinline__ unsigned xb_ld(unsigned* p)              { return __hip_atomic_load(p, __ATOMIC_RELAXED, __HIP_MEMORY_SCOPE_AGENT); }
__device__ __forceinline__ unsigned xb_add(unsigned* p, unsigned v) { return __hip_atomic_fetch_add(p, v, __ATOMIC_RELAXED, __HIP_MEMORY_SCOPE_AGENT); }
__device__ __forceinline__ unsigned xb_xcc_id() { return (unsigned)__builtin_amdgcn_s_getreg((3 << 11) | 20) & 0xFu; }
#define XB_SPIN(cond, bar) do { unsigned _sp = 0; while (cond) { __builtin_amdgcn_s_sleep(1); \
    if ((++_sp & 255u) == 0u) { if (xb_ld(&(bar)[XB_TMO])) break; if (_sp > XB_SPIN_CAP) { atomicAdd(&(bar)[XB_TMO], 1u); break; } } } } while (0)

struct XcdBarrier {
    unsigned* bar; unsigned x;
    volatile LAS unsigned* st;
};

__device__ __forceinline__ XcdBarrier xcd_barrier_post(unsigned* bar, volatile LAS unsigned* st) {
    XcdBarrier b; b.bar = bar; b.x = xb_xcc_id(); b.st = st;
    if (threadIdx.x == 0) (void)xb_add(&bar[XB_XCNT(b.x)], 1u);
    return b;
}
__device__ __forceinline__ void xcd_barrier_complete(unsigned* bar, unsigned x, unsigned& nloc, unsigned& nx) {
    const unsigned G = gridDim.x * gridDim.y * gridDim.z;
    unsigned sum, cnt, mine, sp = 0u;
    for (;;) {
        sum = 0u; cnt = 0u; mine = 0u;
#pragma unroll
        for (unsigned j = 0; j < 16; ++j) { const unsigned c = xb_ld(&bar[XB_XCNT(j)]); sum += c; cnt += (c > 0u) ? 1u : 0u; mine = (j == x) ? c : mine; }
        if (sum == G) break;
        __builtin_amdgcn_s_sleep(1);
        if ((++sp & 255u) == 0u) { if (xb_ld(&bar[XB_TMO])) break; if (sp > XB_SPIN_CAP) { atomicAdd(&bar[XB_TMO], 1u); break; } }
    }
    nloc = mine > 0u ? mine : 1u; nx = cnt > 0u ? cnt : 1u;
}

__device__ __noinline__ void xcd_barrier(const XcdBarrier b) {
    asm volatile("s_waitcnt vmcnt(0)" ::: "memory");
    __syncthreads();
    if (threadIdx.x == 0) {
        unsigned* bar = b.bar;
        __builtin_amdgcn_s_waitcnt(0);
        unsigned nloc = b.st[0], nx = b.st[1];
        if (nloc == 0u) { xcd_barrier_complete(bar, b.x, nloc, nx); b.st[0] = nloc; b.st[1] = nx; }
        const unsigned old = xb_add(&bar[XB_XSUB(b.x)], 1u);
        const unsigned gen = old / nloc;
        if (old + 1u == (gen + 1u) * nloc) {
            __builtin_amdgcn_fence(__ATOMIC_RELEASE, "agent");
            asm volatile("s_waitcnt vmcnt(0)" ::: "memory");
            const unsigned og = xb_add(&bar[XB_TOP], 1u);
            const unsigned tg = og / nx;
            if (og + 1u == (tg + 1u) * nx) xb_add(&bar[XB_TOPGEN], 1u);
            else XB_SPIN(xb_ld(&bar[XB_TOPGEN]) == tg, bar);
            __builtin_amdgcn_fence(__ATOMIC_ACQUIRE, "agent");
            xb_add(&bar[XB_XGEN(b.x)], 1u);
            asm volatile("s_waitcnt vmcnt(0)" ::: "memory");
        } else {
            XB_SPIN(xb_ld(&bar[XB_XGEN(b.x)]) == gen, bar);
            __builtin_amdgcn_fence(__ATOMIC_ACQUIRE, "agent");
            asm volatile("s_waitcnt vmcnt(0)" ::: "memory");
        }
    }
    __syncthreads();
}
namespace att {
enum { M_FOX = 0, M_MOBA = 1, M_SEL = 2, M_WIN = 3, M_CMP = 4 };
constexpr int NW = 8, QBLK = 32, KVBLK = 64, D = 128;
constexpr int SHM_V = KVBLK * D * 2, SHM_K = KVBLK * D * 2;
constexpr int L_WS = 2 * SHM_V + 2 * SHM_K;
constexpr int L_AUX = L_WS + NW * 64 * 4;
constexpr int L_BITS = L_AUX + 32768;
constexpr int L_END = L_BITS + 1024;
constexpr float THR = 8.f;
constexpr float SCALE = SM_SCALE;

#define KSWZ(row, colB) ((row) * 256 + ((colB) ^ (((row) & 7) << 4)))
#define SBAR() __builtin_amdgcn_sched_barrier(0)
__device__ __forceinline__ int v_st(int k, int c) { const int kk = (k & ~0xC) | ((k & 4) << 1) | ((k & 8) >> 1); return ((kk >> 3) * 4 + (c >> 5)) * 512 + ((kk & 7) * 32 + (c & 31)) * 2; }
__device__ __forceinline__ int v_rd_base(int lane) { return ((lane & 3) << 3) | (((lane >> 2) & 3) << 6) | (((lane >> 4) & 1) << 5) | (((lane >> 5) & 1) << 8); }
constexpr int v_rd_off(int d0, int ks, int half) { return d0 * 512 + ks * 4096 + half * 2048; }
__device__ __forceinline__ int crow(int r, int hi) { return (r & 3) + 8 * (r >> 2) + 4 * hi; }

__device__ __forceinline__ void mask_tile(f32x16& p0, f32x16& p1, int dq, unsigned W) {
    const float NEG = -__builtin_inff();
#pragma unroll
    for (int r = 0; r < 16; ++r) {
        const int c = (r & 3) + 8 * (r >> 2);
        if ((unsigned)(dq - c) >= W) p0[r] = NEG;
        if ((unsigned)(dq - c - 32) >= W) p1[r] = NEG;
    }
}
template <bool FOXCUT = false>
__device__ __forceinline__ bool partialSM(f32x16& p0, f32x16& p1, float& m_reg, float& mn, float& alpha) {
    float pmax = p0[0]; for (int r = 1; r < 16; ++r) pmax = fmaxf(pmax, p0[r]); for (int r = 0; r < 16; ++r) pmax = fmaxf(pmax, p1[r]);
    { auto rr = __builtin_amdgcn_permlane32_swap(__float_as_uint(pmax), __float_as_uint(pmax), false, false);
      pmax = fmaxf(__uint_as_float(rr[0]), __uint_as_float(rr[1])); }
    constexpr float C2 = 1.4426950408889634f * SCALE;
    if (FOXCUT && __all(pmax < m_reg - 32.f / SCALE)) { mn = m_reg; alpha = 1.f; return false; }
    if (__builtin_expect(__all((pmax - m_reg) * SCALE <= THR), 1)) { mn = m_reg; alpha = 1.f; }
    else { mn = fmaxf(m_reg, pmax); alpha = __builtin_amdgcn_exp2f((m_reg - mn) * C2); m_reg = mn; }
    const float mnL = -mn * C2;
    for (int r = 0; r < 16; ++r) p0[r] = fmaf(p0[r], C2, mnL); for (int r = 0; r < 16; ++r) p1[r] = fmaf(p1[r], C2, mnL);
    for (int r = 0; r < 16; ++r) p0[r] = __builtin_amdgcn_exp2f(p0[r]);
    return true;
}
__device__ __forceinline__ void finishSM(f32x16& p0, f32x16& p1, float alpha, float& l_reg, bf16x8& pa0, bf16x8& pa1, bf16x8& pa2, bf16x8& pa3) {
    for (int r = 0; r < 16; ++r) p1[r] = __builtin_amdgcn_exp2f(p1[r]);
    float ps = 0; for (int r = 0; r < 16; ++r) ps += p0[r]; for (int r = 0; r < 16; ++r) ps += p1[r];
    { auto rr = __builtin_amdgcn_permlane32_swap(__float_as_uint(ps), __float_as_uint(ps), false, false);
      ps = __uint_as_float(rr[0]) + __uint_as_float(rr[1]); }
    l_reg = l_reg * alpha + ps;
#define PK4(P, B_, OUT) do { unsigned a0 = cvtpk(P[B_+0], P[B_+1]), a1 = cvtpk(P[B_+2], P[B_+3]);                          \
        unsigned b0 = cvtpk(P[B_+4], P[B_+5]), b1 = cvtpk(P[B_+6], P[B_+7]);                                             \
        auto r0 = __builtin_amdgcn_permlane32_swap(a0, b0, false, false); auto r1 = __builtin_amdgcn_permlane32_swap(a1, b1, false, false); \
        u32x4 w = {r0[0], r1[0], r0[1], r1[1]}; OUT = *reinterpret_cast<bf16x8*>(&w); } while (0)
    PK4(p0, 0, pa0); PK4(p0, 8, pa1); PK4(p1, 0, pa2); PK4(p1, 8, pa3);
#undef PK4
}
struct Init { float cq; const float* ck; unsigned bits; const unsigned* tokbits; };
template <int KB, int MODE>
__device__ __forceinline__ void qkt(f32x16& p0, f32x16& p1, const char* K_lds, int r32, int hi, const bf16x8* qr, bool act, int kb, const Init& I) {
    const float NEG = -__builtin_inff();
    if ((MODE == M_SEL || MODE == M_FOX) && !act) return;
    if constexpr (MODE == M_FOX) {
        const float* c = I.ck + kb + 4 * hi;
#pragma unroll
        for (int g = 0; g < 4; ++g) { const f32x4 a = *(const f32x4*)(c + 8 * g), b = *(const f32x4*)(c + 32 + 8 * g);
#pragma unroll
            for (int i = 0; i < 4; ++i) { p0[4 * g + i] = a[i]; p1[4 * g + i] = b[i]; } }
    } else if constexpr (MODE == M_MOBA) {
        const float v = ((I.bits >> (kb >> 8)) & 1u) ? 0.f : NEG;
#pragma unroll
        for (int r = 0; r < 16; ++r) { p0[r] = v; p1[r] = v; }
    } else if constexpr (MODE == M_SEL) {
        const int j = kb >> 6; const unsigned w = I.tokbits[j >> 5]; const float v = ((w >> (j & 31)) & 1u) ? 0.f : NEG;
#pragma unroll
        for (int r = 0; r < 16; ++r) { p0[r] = v; p1[r] = v; }
    } else { p0 = f32x16{}; p1 = f32x16{}; }
    int kad[4];
#pragma unroll
    for (int dd = 0; dd < 4; ++dd) kad[dd] = (int)(uintptr_t)K_lds + KSWZ(r32, (dd * 16 + hi * 8) * 2);
    bf16x8 f0, f1, f2, f3;
#define KRD(dst, d0, w) asm volatile("ds_read_b128 %0, %1 offset:%2" : "=v"(dst) : "v"(kad[(d0) & 3]), "i"(KB * SHM_K + ((d0) >> 2) * 128 + (w) * 8192) : "memory")
#define KWT(n, x) asm volatile("s_waitcnt lgkmcnt(" #n ")" : "+v"(x) :: "memory")
#define KMM(P, f, d0) P = __builtin_amdgcn_mfma_f32_32x32x16_bf16(f, qr[d0], P, 0, 0, 0)
    KRD(f0, 0, 0); KRD(f1, 0, 1); KRD(f2, 1, 0); KRD(f3, 1, 1);
    KWT(3, f0); KMM(p0, f0, 0); KRD(f0, 2, 0);  KWT(3, f1); KMM(p1, f1, 0); KRD(f1, 2, 1);
    KWT(3, f2); KMM(p0, f2, 1); KRD(f2, 3, 0);  KWT(3, f3); KMM(p1, f3, 1); KRD(f3, 3, 1);
    KWT(3, f0); KMM(p0, f0, 2); KRD(f0, 4, 0);  KWT(3, f1); KMM(p1, f1, 2); KRD(f1, 4, 1);
    KWT(3, f2); KMM(p0, f2, 3); KRD(f2, 5, 0);  KWT(3, f3); KMM(p1, f3, 3); KRD(f3, 5, 1);
    KWT(3, f0); KMM(p0, f0, 4); KRD(f0, 6, 0);  KWT(3, f1); KMM(p1, f1, 4); KRD(f1, 6, 1);
    KWT(3, f2); KMM(p0, f2, 5); KRD(f2, 7, 0);  KWT(3, f3); KMM(p1, f3, 5); KRD(f3, 7, 1);
    KWT(3, f0); KMM(p0, f0, 6);                 KWT(2, f1); KMM(p1, f1, 6);
    KWT(1, f2); KMM(p0, f2, 7);                 KWT(0, f3); KMM(p1, f3, 7);
#undef KRD
#undef KWT
#undef KMM
}
template <int VB, bool SK>
__device__ __forceinline__ void pv_tile(f32x16* o, int vb0, bf16x8 pa0, bf16x8 pa1, bf16x8 pa2, bf16x8 pa3, bool act) {
    if (SK && !act) return;
    s16x4 l0, l1, l2, l3, h0, h1, h2, h3;
#define TRRD(dst, off) asm volatile("ds_read_b64_tr_b16 %0, %1 offset:%2" : "=&v"(dst) : "v"(vb0), "i"(off) : "memory")
#define VRD2(d0, j) do { constexpr int b_ = VB * SHM_V + v_rd_off(d0, 0, 0) + (j) * 4096; TRRD(l##j, b_); TRRD(h##j, b_ + 2048); } while (0)
#define VFR(j) (bf16x8){l##j[0], l##j[1], l##j[2], l##j[3], h##j[0], h##j[1], h##j[2], h##j[3]}
#define VWT(n) do { asm volatile("s_waitcnt lgkmcnt(" #n ")" : "+v"(l0), "+v"(l1), "+v"(l2), "+v"(l3), "+v"(h0), "+v"(h1), "+v"(h2), "+v"(h3) :: "memory"); } while (0)
    VRD2(0, 0); VRD2(0, 1); VRD2(0, 2); VRD2(0, 3);
    VWT(6); o[0] = __builtin_amdgcn_mfma_f32_32x32x16_bf16(pa0, VFR(0), o[0], 0, 0, 0); VRD2(1, 0);
    VWT(6); o[0] = __builtin_amdgcn_mfma_f32_32x32x16_bf16(pa1, VFR(1), o[0], 0, 0, 0); VRD2(1, 1);
    VWT(6); o[0] = __builtin_amdgcn_mfma_f32_32x32x16_bf16(pa2, VFR(2), o[0], 0, 0, 0); VRD2(1, 2);
    VWT(6); o[0] = __builtin_amdgcn_mfma_f32_32x32x16_bf16(pa3, VFR(3), o[0], 0, 0, 0); VRD2(1, 3);
    VWT(6); o[1] = __builtin_amdgcn_mfma_f32_32x32x16_bf16(pa0, VFR(0), o[1], 0, 0, 0); VRD2(2, 0);
    VWT(6); o[1] = __builtin_amdgcn_mfma_f32_32x32x16_bf16(pa1, VFR(1), o[1], 0, 0, 0); VRD2(2, 1);
    VWT(6); o[1] = __builtin_amdgcn_mfma_f32_32x32x16_bf16(pa2, VFR(2), o[1], 0, 0, 0); VRD2(2, 2);
    VWT(6); o[1] = __builtin_amdgcn_mfma_f32_32x32x16_bf16(pa3, VFR(3), o[1], 0, 0, 0); VRD2(2, 3);
    VWT(6); o[2] = __builtin_amdgcn_mfma_f32_32x32x16_bf16(pa0, VFR(0), o[2], 0, 0, 0); VRD2(3, 0);
    VWT(6); o[2] = __builtin_amdgcn_mfma_f32_32x32x16_bf16(pa1, VFR(1), o[2], 0, 0, 0); VRD2(3, 1);
    VWT(6); o[2] = __builtin_amdgcn_mfma_f32_32x32x16_bf16(pa2, VFR(2), o[2], 0, 0, 0); VRD2(3, 2);
    VWT(6); o[2] = __builtin_amdgcn_mfma_f32_32x32x16_bf16(pa3, VFR(3), o[2], 0, 0, 0); VRD2(3, 3);
    VWT(6); o[3] = __builtin_amdgcn_mfma_f32_32x32x16_bf16(pa0, VFR(0), o[3], 0, 0, 0);
    VWT(4); o[3] = __builtin_amdgcn_mfma_f32_32x32x16_bf16(pa1, VFR(1), o[3], 0, 0, 0);
    VWT(2); o[3] = __builtin_amdgcn_mfma_f32_32x32x16_bf16(pa2, VFR(2), o[3], 0, 0, 0);
    VWT(0); o[3] = __builtin_amdgcn_mfma_f32_32x32x16_bf16(pa3, VFR(3), o[3], 0, 0, 0);
#undef TRRD
#undef VRD2
#undef VFR
#undef VWT
}

constexpr int L_STG = 139264;
__device__ __forceinline__ void stg_write(char* stg, const f32x16* o, const float (&rli)[16], int q, int r32, int hi) {
#pragma unroll
    for (int rr = 0; rr < 4; ++rr)
#pragma unroll
        for (int d0 = 0; d0 < 4; ++d0) { const int col = d0 * 32 + r32, rc = rr + 4 * hi;
            const float v = o[d0][4 * q + rr] * rli[4 * q + rr];
            *(unsigned short*)(stg + rc * 256 + ((((col >> 3) ^ (hi << 2)) << 4) | ((col & 7) << 1))) = (unsigned short)cvtpk(v, v); }
}
__device__ __forceinline__ u32x4 stg_read(const char* stg, int i, int lane, int& rc, int& ch) {
    const int idx = i * 64 + lane; rc = idx >> 4; ch = idx & 15;
    return *(const u32x4*)(stg + rc * 256 + ((ch ^ ((rc >> 2) << 2)) << 4));
}

struct Ref { const bf16_t* Q; const bf16_t* K; const bf16_t* V; int kvp, P0, skv, jlo; };
struct Out { bf16_t* O; float* scr; const float* gf; int br; };
template <int MODE, bool LOADQ>
__device__ __forceinline__ void attn_pass(const Ref& R, char* lds, bf16x8 (&qr)[8], const Out& E, float& m_out, float& l_out, unsigned long long wor_lo, unsigned long long wor_hi) {
    constexpr bool NSA = (MODE == M_SEL || MODE == M_WIN || MODE == M_CMP);
    constexpr bool SK = (MODE == M_SEL || MODE == M_FOX);
    int tid_ = threadIdx.x; asm volatile("" : "+v"(tid_));
    const int tid = tid_, wid = __builtin_amdgcn_readfirstlane(tid >> 6), lane = tid & 63, r32 = lane & 31, hi = lane >> 5;
    const int pos = NSA ? R.P0 + 8 * wid + (r32 >> 2) : R.P0 + 32 * wid + r32;
    const int qlo_p = NSA ? R.P0 + 8 * wid : R.P0 + 32 * wid, qhi_p = NSA ? qlo_p + 7 : qlo_p + 31, P1 = R.P0 + (NSA ? 63 : 255);
    const int mp = (MODE == M_CMP) ? ((pos - 31) >> 4) : pos;
    const int qlo = (MODE == M_CMP) ? ((qlo_p - 31) >> 4) : qlo_p, qhi = (MODE == M_CMP) ? ((qhi_p - 31) >> 4) : qhi_p, mP1 = (MODE == M_CMP) ? ((P1 - 31) >> 4) : P1;
    constexpr int W = (MODE == M_WIN) ? 512 : (1 << 30);
    int j_lo = R.jlo; if (MODE == M_WIN) { const int lowk = R.P0 - 511; j_lo = lowk > 0 ? lowk / KVBLK : 0; }
    int j_hi = mP1 / KVBLK + 1; if (j_hi > R.skv / KVBLK) j_hi = R.skv / KVBLK;
    const int NT = j_hi - j_lo;
    const int wjlo = (MODE == M_FOX) ? (int)wor_lo : 0;
    const int qm = mp - 4 * hi;
    char* V_lds = lds; char* K_lds = lds + 2 * SHM_V;
    float* ws = (float*)(lds + L_WS) + wid * 64; float* li_l = ws, * al_l = ws + 32;
    float m_reg = -1e30f, l_reg = 0; f32x16 o[4] = {};
    const int sr = tid >> 4, sc = (tid & 15) * 8, vst0 = v_st(sr, sc), vst1 = v_st(32 + sr, sc), kws = KSWZ(sr, sc * 2);
    const int vb0 = (int)(uintptr_t)V_lds + v_rd_base(lane);
    const bf16_t* Kh = R.K; const bf16_t* Vh = R.V; const int kvp = R.kvp;
    Init I; I.cq = 0.f; I.ck = (const float*)(lds + L_AUX); I.bits = 0u; I.tokbits = (const unsigned*)(lds + L_BITS);
    if constexpr (MODE == M_MOBA) I.bits = ((const unsigned*)(lds + L_BITS))[32 * wid + r32];
    if constexpr (MODE == M_SEL) I.tokbits = (const unsigned*)(lds + L_BITS) + (8 * wid + (r32 >> 2)) * 4;
    bf16x8 st_v0, st_v1, st_k0, st_k1;
#define ROWP(p, k0, rr) ((p) + (size_t)((k0) + (rr)) * kvp + sc)
#define SLOAD_H(k0) do { st_v0 = *(const bf16x8*)ROWP(Vh, k0, sr); st_v1 = *(const bf16x8*)ROWP(Vh, k0, 32 + sr);              \
                         st_k0 = *(const bf16x8*)ROWP(Kh, k0, sr); st_k1 = *(const bf16x8*)ROWP(Kh, k0, 32 + sr); } while (0)
#define SWRITE_HK(bf) do { *(bf16x8*)(K_lds + (bf) * SHM_K + kws) = st_k0; *(bf16x8*)(K_lds + (bf) * SHM_K + kws + 32 * 256) = st_k1; } while (0)
#define SWRITE_HV(bf) do { *(bf16x8*)(V_lds + (bf) * SHM_V + vst0) = st_v0; *(bf16x8*)(V_lds + (bf) * SHM_V + vst1) = st_v1; } while (0)
#define SWRITE_H(bf) do { SWRITE_HV(bf); SWRITE_HK(bf); } while (0)
#define RESC(a) do { if (__any((a) < 1.f)) { if (hi == 0) al_l[r32] = (a); asm volatile("s_waitcnt lgkmcnt(0)" ::: "memory");              \
                     for (int d_ = 0; d_ < 4; ++d_) for (int r = 0; r < 16; ++r) o[d_][r] *= al_l[crow(r, hi)]; } } while (0)
#define KBASE(t) ((MODE == M_FOX ? (j_hi - 1 - (t)) : (j_lo + (t))) * KVBLK)
#define SELBIT(t) ((((j_lo + (t)) < 64 ? (wor_lo >> (j_lo + (t))) : (wor_hi >> ((j_lo + (t)) - 64))) & 1ull) != 0ull)
#define FOXACT(t) (KBASE(t) <= qhi && (j_hi - 1 - (t)) >= wjlo)
#define ACT(t) (!SK || (MODE == M_FOX ? FOXACT(t) : SELBIT(t)))
#define PSM(P0_, P1_, mn_, al_, t, LV_) do { if (ACT(t)) LV_ = partialSM<MODE == M_FOX>(P0_, P1_, m_reg, mn_, al_); else { al_ = 1.f; LV_ = false; } } while (0)
#define FSM(P0_, P1_, al_, LV_) do { if (LV_) finishSM(P0_, P1_, al_, l_reg, pa0, pa1, pa2, pa3); } while (0)
#define MASKT(P0_, P1_, t) do { const int kb_ = KBASE(t); if (ACT(t) && (kb_ + KVBLK - 1 > qlo || kb_ <= qhi - W)) mask_tile(P0_, P1_, qm - kb_, (unsigned)W); } while (0)
    if constexpr (LOADQ) {
        const bf16_t* qrow = NSA ? R.Q + (size_t)(8 * wid + (r32 >> 2)) * PW + (r32 & 3) * 128 : R.Q + (size_t)(32 * wid + r32) * PW;
#pragma unroll
        for (int d0 = 0; d0 < 8; ++d0) qr[d0] = *(const bf16x8*)(qrow + d0 * 16 + hi * 8);
    }
    SLOAD_H(KBASE(0)); VM_WAIT(); SWRITE_HK(0);
    __syncthreads();
    f32x16 pA0, pA1, pB0, pB1; float mnA, mnB, alA, alB; bf16x8 pa0, pa1, pa2, pa3;
    SWRITE_HV(0); SBAR();
    if (NT > 1) SLOAD_H(KBASE(1));
    SBAR(); qkt<0, MODE>(pA0, pA1, K_lds, r32, hi, qr, ACT(0), KBASE(0), I);
    bool lvA = true, lvB = true;
    MASKT(pA0, pA1, 0); PSM(pA0, pA1, mnA, alA, 0, lvA);
    if (NT > 1) { VM_WAIT(); SWRITE_H(1); }
    __syncthreads();
#define HALF_STEP(PX0, PX1, mnX, alX, lvX, PY0, PY1, alY, lvY, t, KB, VB, SB) do {                                                      \
        SBAR(); if ((t) + 1 < NT) { SLOAD_H(KBASE((t) + 1)); SBAR(); }         \
        qkt<KB, MODE>(PX0, PX1, K_lds, r32, hi, qr, ACT(t), KBASE(t), I);                                                     \
        FSM(PY0, PY1, alY, lvY); SBAR();                                                                                      \
        pv_tile<VB, true>(o, vb0, pa0, pa1, pa2, pa3, lvY); MASKT(PX0, PX1, (t)); PSM(PX0, PX1, mnX, alX, (t), lvX);          \
        __syncthreads();                                                                                                      \
        if ((t) + 1 < NT) { VM_WAIT(); SWRITE_H(SB); }                                                                        \
        RESC(alX); __syncthreads(); } while (0)
    for (int t = 1; t + 1 < NT; t += 2) {
        HALF_STEP(pB0, pB1, mnB, alB, lvB, pA0, pA1, alA, lvA, t, 1, 0, 0);
        HALF_STEP(pA0, pA1, mnA, alA, lvA, pB0, pB1, alB, lvB, t + 1, 0, 1, 1);
    }
    const bool even = (NT & 1) == 0;
    if (even) { SBAR(); qkt<1, MODE>(pB0, pB1, K_lds, r32, hi, qr, ACT(NT - 1), KBASE(NT - 1), I); SBAR(); }
    FSM(pA0, pA1, alA, lvA); SBAR();
    pv_tile<0, true>(o, vb0, pa0, pa1, pa2, pa3, lvA);
    if (even) { MASKT(pB0, pB1, NT - 1); PSM(pB0, pB1, mnB, alB, NT - 1, lvB); __syncthreads(); RESC(alB);
        FSM(pB0, pB1, alB, lvB); SBAR(); pv_tile<1, true>(o, vb0, pa0, pa1, pa2, pa3, lvB); }
    SBAR();
    m_out = m_reg; l_out = l_reg;
    {
        float f = l_reg > 0.f ? 1.f / l_reg : 0.f;
        if constexpr (NSA) f *= E.gf[(size_t)(8 * wid + (r32 >> 2)) * 32 + (r32 & 3) * 3 + E.br];
        if (hi == 0) li_l[r32] = f;
        asm volatile("s_waitcnt lgkmcnt(0)" ::: "memory");
    }
    float rli[16];
#pragma unroll
    for (int r = 0; r < 16; ++r) rli[r] = li_l[crow(r, hi)];
    char* stg = lds + L_STG + wid * 2048;
    bf16_t* pbuf = (bf16_t*)E.scr;
#pragma unroll
    for (int q = 0; q < 4; ++q) {
        stg_write(stg, o, rli, q, r32, hi);
        asm volatile("" ::: "memory");
#pragma unroll
        for (int i = 0; i < 2; ++i) { int rc, ch; const u32x4 w = stg_read(stg, i, lane, rc, ch); const int orow = 8 * q + rc;
            if constexpr (!NSA) *(u32x4*)(E.O + (size_t)(wid * QBLK + orow) * DM + ch * 8) = w;
            else if constexpr (MODE == M_CMP || MODE == M_SEL) *(u32x4*)(pbuf + (size_t)((MODE == M_SEL ? 256 : 0) + wid * QBLK + orow) * 128 + ch * 8) = w;
            else {
                const u32x4 a = *(const u32x4*)(pbuf + (size_t)(wid * QBLK + orow) * 128 + ch * 8), b = *(const u32x4*)(pbuf + (size_t)(256 + wid * QBLK + orow) * 128 + ch * 8);
                u32x4 r;
#pragma unroll
                for (int j = 0; j < 4; ++j) {
                    const float lo = __builtin_bit_cast(float, w[j] << 16) + __builtin_bit_cast(float, a[j] << 16) + __builtin_bit_cast(float, b[j] << 16);
                    const float hh = __builtin_bit_cast(float, w[j] & 0xffff0000u) + __builtin_bit_cast(float, a[j] & 0xffff0000u) + __builtin_bit_cast(float, b[j] & 0xffff0000u);
                    r[j] = cvtpk(lo, hh); }
                *(u32x4*)(E.O + (size_t)(8 * wid + (orow >> 2)) * DM + (orow & 3) * 128 + ch * 8) = r; }
        }
        asm volatile("" ::: "memory");
    }
    __syncthreads();
#undef ROWP
#undef SLOAD_H
#undef SWRITE_HK
#undef SWRITE_HV
#undef SWRITE_H
#undef RESC
#undef KBASE
#undef SELBIT
#undef FOXACT
#undef ACT
#undef MASKT
#undef PSM
#undef FSM
#undef HALF_STEP
}

__device__ __forceinline__ void cmp_imp_pass(const bf16_t* Kc  , int P0, char* lds, const bf16x8 (&qr)[8], float m_reg, float l_reg) {
    int tid_ = threadIdx.x; asm volatile("" : "+v"(tid_));
    const int tid = tid_, wid = __builtin_amdgcn_readfirstlane(tid >> 6), lane = tid & 63, r32 = lane & 31, hi = lane >> 5;
    const int pos = P0 + 8 * wid + (r32 >> 2), mp = (pos - 31) >> 4, qm = mp - 4 * hi;
    const int mP1 = (P0 + 63 - 31) >> 4; int NT = mP1 / KVBLK + 1; if (NT > 8) NT = 8;
    float* imp = (float*)(lds + L_AUX);
    const int sr = tid >> 4, sc = (tid & 15) * 8, kws = KSWZ(sr, sc * 2);
    constexpr float C2 = 1.4426950408889634f * SCALE;
    const float mL = -m_reg * C2, rl = l_reg > 0.f ? 1.f / l_reg : 0.f;
    Init I; I.cq = 0.f; I.ck = nullptr; I.bits = 0u; I.tokbits = nullptr;
    const int tb = 8 * wid + (r32 >> 2);
    bf16x8 ka[8], kb[8];
#define CIP_LOAD(dst, base) do { _Pragma("unroll") for (int t = 0; t < 4; ++t) if ((base) + t < NT) {                              \
        dst[2 * t] = *(const bf16x8*)(Kc + (size_t)(((base) + t) * KVBLK + sr) * 128 + sc); dst[2 * t + 1] = *(const bf16x8*)(Kc + (size_t)(((base) + t) * KVBLK + 32 + sr) * 128 + sc); } } while (0)
#define CIP_WRITE(src, base) do { _Pragma("unroll") for (int t = 0; t < 4; ++t) if ((base) + t < NT) {                             \
        *(bf16x8*)(lds + t * SHM_K + kws) = src[2 * t]; *(bf16x8*)(lds + t * SHM_K + kws + 32 * 256) = src[2 * t + 1]; } } while (0)
#define CIP_TILE(t_) do { const int kb_ = (t_) * KVBLK; f32x16 p0, p1;                                                               \
        qkt<0, M_CMP>(p0, p1, lds + ((t_) & 3) * SHM_K, r32, hi, qr, true, kb_, I);                                                 \
        mask_tile(p0, p1, qm - kb_, 1u << 30);                                                                                      \
        _Pragma("unroll") for (int r = 0; r < 16; ++r) { p0[r] = __builtin_amdgcn_exp2f(fmaf(p0[r], C2, mL)) * rl; p1[r] = __builtin_amdgcn_exp2f(fmaf(p1[r], C2, mL)) * rl; }   \
        _Pragma("unroll") for (int half = 0; half < 2; ++half) _Pragma("unroll") for (int g = 0; g < 4; ++g) {                      \
            float s4, e3;                                                                                                           \
            if (half == 0) { s4 = (p0[4 * g] + p0[4 * g + 1]) + (p0[4 * g + 2] + p0[4 * g + 3]); e3 = p0[4 * g + 3]; }              \
            else { s4 = (p1[4 * g] + p1[4 * g + 1]) + (p1[4 * g + 2] + p1[4 * g + 3]); e3 = p1[4 * g + 3]; }                        \
            s4 += __shfl_xor(s4, 1); s4 += __shfl_xor(s4, 2); e3 += __shfl_xor(e3, 1); e3 += __shfl_xor(e3, 2);     \
            const int n = (kb_ >> 2) + 8 * half + 2 * g + hi;                                                                        \
            if ((r32 & 3) == 0) { atomicAdd(&imp[tb * 128 + n], s4); if (n + 1 < 128) atomicAdd(&imp[tb * 128 + n + 1], e3); } } } while (0)
    CIP_LOAD(ka, 0);
    __syncthreads();
    CIP_WRITE(ka, 0);
    if (NT > 4) CIP_LOAD(kb, 4);
    __syncthreads();
    for (int t = 0; t < 4 && t < NT; ++t) CIP_TILE(t);
    if (NT > 4) {
        __syncthreads();
        CIP_WRITE(kb, 4);
        __syncthreads();
        for (int t = 4; t < NT; ++t) CIP_TILE(t);
    }
    __syncthreads();
#undef CIP_LOAD
#undef CIP_WRITE
#undef CIP_TILE
}

constexpr int MB_WS = 131072 + 4096;
__device__ __forceinline__ void moba_block_load(const bf16_t* K  , const bf16_t* V, char* lds) {
    int tid_ = threadIdx.x; asm volatile("" : "+v"(tid_));
    const int tid = tid_, sr = tid >> 4, sc = (tid & 15) * 8, vst0 = v_st(sr, sc), vst1 = v_st(32 + sr, sc), kws = KSWZ(sr, sc * 2);
    bf16x8 kk[8], vv[8];
#pragma unroll
    for (int t = 0; t < 4; ++t) { kk[2 * t] = *(const bf16x8*)(K + (size_t)(64 * t + sr) * PW + sc); kk[2 * t + 1] = *(const bf16x8*)(K + (size_t)(64 * t + 32 + sr) * PW + sc);
        vv[2 * t] = *(const bf16x8*)(V + (size_t)(64 * t + sr) * PW + sc); vv[2 * t + 1] = *(const bf16x8*)(V + (size_t)(64 * t + 32 + sr) * PW + sc); }
    __syncthreads();
#pragma unroll
    for (int t = 0; t < 4; ++t) { *(bf16x8*)(lds + 65536 + t * SHM_K + kws) = kk[2 * t]; *(bf16x8*)(lds + 65536 + t * SHM_K + kws + 32 * 256) = kk[2 * t + 1];
        *(bf16x8*)(lds + t * SHM_V + vst0) = vv[2 * t]; *(bf16x8*)(lds + t * SHM_V + vst1) = vv[2 * t + 1]; }
    __syncthreads();
}
template <bool CAUSAL>
__device__ __forceinline__ void moba_block_groups(const bf16_t* Qb  , const unsigned* lst, int cnt, int jblk, bf16_t* part, float* stat, char* lds) {
    int tid_ = threadIdx.x; asm volatile("" : "+v"(tid_));
    const int tid = tid_, wid = __builtin_amdgcn_readfirstlane(tid >> 6), lane = tid & 63, r32 = lane & 31, hi = lane >> 5;
    char* K_lds = lds + 65536 - 2 * SHM_V;
    K_lds = lds + 65536;
    const int vb0 = (int)(uintptr_t)lds + v_rd_base(lane);
    float* ws = (float*)(lds + MB_WS) + wid * 96; float* li_l = ws, * al_l = ws + 32; unsigned* en_l = (unsigned*)(ws + 64);
    const int ngroups = (cnt + 31) >> 5;
    Init I; I.cq = 0.f; I.ck = nullptr; I.bits = 0u; I.tokbits = nullptr;
#define RESC(a) do { if (__any((a) < 1.f)) { if (hi == 0) al_l[r32] = (a); asm volatile("s_waitcnt lgkmcnt(0)" ::: "memory");              \
                     for (int d_ = 0; d_ < 4; ++d_) for (int r = 0; r < 16; ++r) o[d_][r] *= al_l[crow(r, hi)]; } } while (0)
    for (int g = wid; g < ngroups; g += NW) {
        const int ri = g * 32 + r32;
        const unsigned e = CAUSAL ? ((unsigned)(jblk * 256 + ri) | (3u << 16)) : lst[ri < cnt ? ri : g * 32];
        const bf16_t* qrow = Qb + (size_t)(e & 0xffffu) * PW;
        bf16x8 qr[8];
#pragma unroll
        for (int d0 = 0; d0 < 8; ++d0) qr[d0] = *(const bf16x8*)(qrow + d0 * 16 + hi * 8);
        if (hi == 0) en_l[r32] = e;
        const int qm = ri - 4 * hi;
        float m_reg = -1e30f, l_reg = 0.f; f32x16 o[4] = {};
        f32x16 pA0, pA1, pB0, pB1; float mnA, mnB, alA, alB; bf16x8 pa0, pa1, pa2, pa3;
#define MSK(P0_, P1_, t) do { if (CAUSAL && (64 * (t) + 63 > 32 * g)) mask_tile(P0_, P1_, qm - 64 * (t), 1u << 30); } while (0)
        SBAR(); qkt<0, M_CMP>(pA0, pA1, K_lds, r32, hi, qr, true, 0, I); MSK(pA0, pA1, 0); partialSM(pA0, pA1, m_reg, mnA, alA); SBAR();
#define NEED(t) (!CAUSAL || (64 * (t) <= 32 * g + 31))
#define STEP(KB, VB, PX0, PX1, mnX, alX, PY0, PY1, alY) do {                                                                   \
            SBAR(); if (NEED(KB)) qkt<KB, M_CMP>(PX0, PX1, K_lds, r32, hi, qr, true, 64 * (KB), I);                             \
            if (NEED((KB) - 1)) finishSM(PY0, PY1, alY, l_reg, pa0, pa1, pa2, pa3); SBAR();                                     \
            pv_tile<VB, true>(o, vb0, pa0, pa1, pa2, pa3, NEED((KB) - 1));                                                      \
            if (NEED(KB)) { MSK(PX0, PX1, KB); partialSM(PX0, PX1, m_reg, mnX, alX); } else alX = 1.f; SBAR();                  \
            RESC(alX); SBAR(); } while (0)
#define LAST(VB, PY0, PY1, alY) do { SBAR(); if (NEED(VB)) finishSM(PY0, PY1, alY, l_reg, pa0, pa1, pa2, pa3); SBAR(); pv_tile<VB, true>(o, vb0, pa0, pa1, pa2, pa3, NEED(VB)); SBAR(); } while (0)
        STEP(1, 0, pB0, pB1, mnB, alB, pA0, pA1, alA);
        STEP(2, 1, pA0, pA1, mnA, alA, pB0, pB1, alB);
        STEP(3, 2, pB0, pB1, mnB, alB, pA0, pA1, alA);
        LAST(3, pB0, pB1, alB);
#undef STEP
#undef LAST
#undef MSK
#undef NEED
        SBAR();
        if (hi == 0) { li_l[r32] = l_reg > 0.f ? 1.f / l_reg : 0.f; float* st = stat + ((size_t)(e & 0xffffu) * 4 + (e >> 16)) * 2; st[0] = m_reg; st[1] = l_reg; }
        asm volatile("s_waitcnt lgkmcnt(0)" ::: "memory");
        {
            float rli[16];
#pragma unroll
            for (int r = 0; r < 16; ++r) rli[r] = li_l[crow(r, hi)];
            char* stg = lds + L_STG + wid * 2048;
#pragma unroll
            for (int q = 0; q < 4; ++q) {
                stg_write(stg, o, rli, q, r32, hi);
                asm volatile("" ::: "memory");
#pragma unroll
                for (int i = 0; i < 2; ++i) { int rc, ch; const u32x4 w = stg_read(stg, i, lane, rc, ch); const unsigned eo = en_l[8 * q + rc];
                    *(u32x4*)(part + ((size_t)(eo & 0xffffu) * 4 + (eo >> 16)) * 128 + ch * 8) = w; }
                asm volatile("" ::: "memory");
            }
        }
        asm volatile("s_waitcnt lgkmcnt(0)" ::: "memory");
    }
#undef RESC
}
#undef KSWZ
}
constexpr int NWAVES = 8;
#ifndef MK_SINGLE
#define MK_SINGLE 1
#endif
#ifndef TOPK_CHECK
#define TOPK_CHECK 0
#endif
#ifndef FOX_T
#define FOX_T 32.0f
#endif
constexpr int N_PRO = 3, PH_PER_LAYER = 10, N_PHASES = N_PRO + PH_PER_LAYER * NL;

constexpr size_t MiB = 1u << 20;
constexpr size_t al256(size_t x) { return (x + 255) & ~(size_t)255; }
constexpr size_t WS_CTL = 0, CTL_ZERO_BYTES = 1 * MiB;
constexpr size_t WS_WIN = 2 * MiB;
constexpr size_t WS_WOUT = WS_WIN + (size_t)NL * NPROJ * DM * 2;
constexpr size_t WS_WUP = WS_WOUT + (size_t)NL * DM * DM * 2;
constexpr size_t WS_WDN = WS_WUP + (size_t)NL * FF * DM * 2;
constexpr size_t WS_W1T = WS_WDN + (size_t)NL * DM * FF * 2;
constexpr size_t WS_CS = WS_W1T + (size_t)NL * 2 * 256 * 4096 * 2;
constexpr size_t WS_MODP = WS_CS + (size_t)MTOK * 32 * 4;
constexpr size_t WS_MODV = WS_MODP + (size_t)NL * 32 * 2 * 12288 * 4;
constexpr size_t WS_B1P = WS_MODV + (size_t)NL * 2 * 6 * 2048 * 4;
constexpr size_t WS_B1 = WS_B1P + (size_t)NL * 2 * 64 * 256 * 4;
constexpr size_t WS_H = al256(WS_B1 + (size_t)NL * 2 * 256 * 4);
constexpr size_t WS_Y = WS_H + (size_t)MTOK * DM * 2;
constexpr size_t WS_OVL = WS_Y + (size_t)MTOK * DM * 4;
constexpr size_t WS_PROJ = WS_OVL;
constexpr size_t WS_KC = WS_PROJ + (size_t)MTOK * PW * 2;
constexpr size_t WS_VC = WS_KC + (size_t)(MTOK + 64) * 128 * 2;
constexpr size_t WS_GF = WS_VC + (size_t)(MTOK + 64) * 128 * 2;
constexpr size_t WS_CUMS = WS_GF + (size_t)MTOK * 32 * 4;
constexpr size_t WS_KMEAN = WS_CUMS + (size_t)16 * SEQ * 4;
constexpr size_t WS_QN = WS_KMEAN + (size_t)8 * 32 * 128 * 4;
constexpr size_t WS_DG = WS_QN + (size_t)16 * SEQ * 4;
constexpr size_t WS_KMX = WS_DG + (size_t)16 * SEQ * 4;
constexpr size_t WS_CPART = WS_KMX + (size_t)16 * 32 * 4 + 2048;
constexpr size_t WS_KCMP = WS_CPART + (size_t)32 * 1024 * 256 * 4;
constexpr size_t WS_VCMP = WS_KCMP + (size_t)2 * 512 * 128 * 2;
constexpr size_t WS_O = WS_VCMP + (size_t)2 * 512 * 128 * 2;
constexpr size_t WS_SCR = WS_O + (size_t)MTOK * DM * 2;
constexpr size_t WS_MLIST = WS_SCR + (size_t)256 * 2 * 256 * 128 * 4;
constexpr size_t WS_MPART = WS_MLIST + (size_t)8 * 32 * 8192 * 4;
constexpr size_t WS_MSTAT = WS_MPART + (size_t)8 * 8192 * 4 * 128 * 2;
constexpr size_t WS_OVL_END = WS_MSTAT + (size_t)8 * 8192 * 4 * 2 * 4;
constexpr size_t WS_U = WS_OVL;
constexpr size_t WS_END = (WS_OVL_END > WS_U + (size_t)MTOK * FF * 2) ? WS_OVL_END : WS_U + (size_t)MTOK * FF * 2;
constexpr int CW_ERR = 0;
constexpr int CW_BAR = 4096;
constexpr int CW_Q = 16384;
constexpr int CW_MC = 20480;
constexpr int LDS_BYTES = 163840;
constexpr int LDSCTL_OFF = 131072, MISC_OFF = LDSCTL_OFF + 320;

struct Args { const float* in[20]; float* out; unsigned char* ws; int ph_lo, ph_hi, use_bar, pad; };

struct Frame {
    LAS unsigned char* lds; char* ldsg; volatile LAS unsigned* MISC; gu32* ctl;
    int vcu, G;
    const float* x; float* out; unsigned char* ws;
};

__device__ __forceinline__ int fresh_tid() { int t = threadIdx.x; asm volatile("" : "+v"(t)); return t; }
__device__ __forceinline__ int fresh_s(int v) { asm volatile("" : "+s"(v)); return v; }
__device__ __forceinline__ unsigned char* fresh(unsigned char* p) { GAS unsigned char* g = (GAS unsigned char*)p; asm volatile("" : "+s"(g)); return (unsigned char*)g; }
__device__ __forceinline__ int proj_src_col(int n) {
    if (n < 2816) return n;
    if (n < 5888) return n + 12;
    if (n < 5900) return n - 3072;
    if (n < 5908) return n;
    return -1;
}
template <bool PROJMAP>
__device__ __forceinline__ void transpose_item(const float* W, int K, int Nsrc, int Nout, bf16_t* WT, LAS float* scr, int item, int lane) {
    const int nblk = Nout / 32, kb = item / nblk, nb = item % nblk, k0 = 64 * kb, n0 = 32 * nb;
    const int nn = n0 + (lane & 31); const int co = PROJMAP ? proj_src_col(nn) : nn;
    float tv[32];
    const float* wp = W + (size_t)(k0 + (lane >> 5)) * Nsrc + (co >= 0 ? co : 0);
#pragma unroll
    for (int i = 0; i < 32; ++i) tv[i] = wp[(size_t)(2 * i) * Nsrc];
#pragma unroll
    for (int i = 0; i < 32; ++i) scr[(2 * i + (lane >> 5)) * 33 + (lane & 31)] = (co >= 0) ? tv[i] : 0.f;
    LDS_WAIT(); asm volatile("" ::: "memory");
    const int c = lane & 7;
#pragma unroll
    for (int j = 0; j < 4; ++j) { const int n = (lane >> 3) + 8 * j; const LAS float* s = scr + (8 * c) * 33 + n;
        u32x4 o; o.x = pk2(s[0 * 33], s[1 * 33]); o.y = pk2(s[2 * 33], s[3 * 33]); o.z = pk2(s[4 * 33], s[5 * 33]); o.w = pk2(s[6 * 33], s[7 * 33]);
        *(GAS u32x4*)(WT + (size_t)(n0 + n) * K + k0 + 8 * c) = o; }
    LDS_WAIT(); asm volatile("" ::: "memory");
}

constexpr int WI_IN = (DM / 64) * (NPROJ / 32), WI_OUT = (DM / 64) * (DM / 32), WI_UP = (DM / 64) * (FF / 32), WI_DN = (FF / 64) * (DM / 32), WI_W1 = (4096 / 64) * (256 / 32);
constexpr int W_ITEMS_LAYER = WI_IN + WI_OUT + WI_UP + WI_DN + 2 * WI_W1;
__device__ __forceinline__ void weight_item(unsigned char* ws_, const Args& a, int l, int r, LAS float* scr, int lane) {
    if (r < WI_IN) { transpose_item<true>(a.in[9] + (size_t)l * DM * PROJ_DIM, DM, PROJ_DIM, NPROJ, (bf16_t*)(ws_ + WS_WIN) + (size_t)l * NPROJ * DM, scr, r, lane); return; } r -= WI_IN;
    if (r < WI_OUT) { transpose_item<false>(a.in[17] + (size_t)l * DM * DM, DM, DM, DM, (bf16_t*)(ws_ + WS_WOUT) + (size_t)l * DM * DM, scr, r, lane); return; } r -= WI_OUT;
    if (r < WI_UP) { transpose_item<false>(a.in[18] + (size_t)l * DM * FF, DM, FF, FF, (bf16_t*)(ws_ + WS_WUP) + (size_t)l * FF * DM, scr, r, lane); return; } r -= WI_UP;
    if (r < WI_DN) { transpose_item<false>(a.in[19] + (size_t)l * FF * DM, FF, DM, DM, (bf16_t*)(ws_ + WS_WDN) + (size_t)l * DM * FF, scr, r, lane); return; } r -= WI_DN;
    if (r < WI_W1) { transpose_item<false>(a.in[13] + (size_t)l * 4096 * 256, 4096, 256, 256, (bf16_t*)(ws_ + WS_W1T) + (size_t)(l * 2 + 0) * 256 * 4096, scr, r, lane); return; } r -= WI_W1;
    transpose_item<false>(a.in[15] + (size_t)l * 4096 * 256, 4096, 256, 256, (bf16_t*)(ws_ + WS_W1T) + (size_t)(l * 2 + 1) * 256 * 4096, scr, r, lane);
}

__device__ __forceinline__ void prologue_a(Frame& F, const Args& a) {
    unsigned char* const ws_ = fresh(F.ws);
    const int BID_ = fresh_s((int)blockIdx.x); (void)BID_; const int tid = fresh_tid(), lane = tid & 63, wave = __builtin_amdgcn_readfirstlane(tid >> 6); (void)lane; (void)wave;
    LAS float* scr = (LAS float*)(F.lds + wave * 16384);
    const int gw = fresh_s(F.vcu) * NWAVES + wave, NGW = F.G * NWAVES;
    for (int it = gw; it < W_ITEMS_LAYER; it += NGW) weight_item(ws_, a, 0, it, scr, lane);
    __syncthreads();
    {
        LAS float* cact = (LAS float*)(F.lds);
        float* MODP = (float*)(ws_ + WS_MODP);
        for (int it = BID_; it < NL * 32 * 6; it += F.G) {
            const int l = it / 192, kc = (it % 192) / 6, jc = it % 6, k0 = kc * 64, j = jc * 2048 + tid * 4;
            __syncthreads();
            if (tid < 128) { const int b = tid >> 6, kk = tid & 63; const float cv = a.in[1][b * DM + k0 + kk]; cact[tid] = cv / (1.f + __expf(-cv)); }
            __syncthreads();
            const float* wp = a.in[3] + ((size_t)l * DM + k0) * 12288 + j;
            f32x4 a0 = {0.f, 0.f, 0.f, 0.f}, a1 = {0.f, 0.f, 0.f, 0.f};
#pragma unroll 8
            for (int kk = 0; kk < 64; ++kk) { const f32x4 w = *(const f32x4*)(wp + (size_t)kk * 12288); a0 += cact[kk] * w; a1 += cact[64 + kk] * w; }
            *(f32x4*)(MODP + ((size_t)(l * 32 + kc) * 2 + 0) * 12288 + j) = a0;
            *(f32x4*)(MODP + ((size_t)(l * 32 + kc) * 2 + 1) * 12288 + j) = a1;
        }
        __syncthreads();
    }
    {
        _Float16* CS = (_Float16*)(ws_ + WS_CS); const int* posi = (const int*)a.in[2];
        for (int i = BID_ * 512 + tid; i < MTOK * 16; i += F.G * 512) { const int m = i >> 4, d = i & 15;
            const float inv = powf(500000.0f, -(float)d / 16.0f); const float ang = (float)posi[m] * inv; float sn, cs; sincosf(ang, &sn, &cs);
            CS[(size_t)m * 32 + d] = (_Float16)cs; CS[(size_t)m * 32 + 16 + d] = (_Float16)sn; }
    }
    {
        float* B1P = (float*)(ws_ + WS_B1P);
        for (int it = BID_ * 2 + (tid >> 8); it < NL * 2 * 64; it += F.G * 2) {
            const int lk = it >> 6, kc = it & 63, l = lk >> 1, kv = lk & 1, j = tid & 255;
            const float* pe = a.in[kv ? 12 : 11] + (size_t)l * 4096 + kc * 64; const float* w1 = a.in[kv ? 15 : 13] + ((size_t)l * 4096 + kc * 64) * 256 + j;
            float wv[64];
#pragma unroll
            for (int kk = 0; kk < 64; ++kk) wv[kk] = w1[(size_t)kk * 256];
            float acc = 0.f;
#pragma unroll
            for (int kk = 0; kk < 64; ++kk) acc += pe[kk] * wv[kk];
            B1P[(size_t)it * 256 + j] = acc;
        }
    }
}
__device__ __forceinline__ void prologue_b(Frame& F, const Args& a) {
    unsigned char* const ws_ = fresh(F.ws);
    const int BID_ = fresh_s((int)blockIdx.x); (void)BID_; const int tid = fresh_tid(), lane = tid & 63, wave = __builtin_amdgcn_readfirstlane(tid >> 6); (void)lane; (void)wave;
    const float* MODP = (const float*)(ws_ + WS_MODP); float* MODV = (float*)(ws_ + WS_MODV);
    for (int i = BID_ * 512 + tid; i < NL * 2 * 6 * 2048; i += F.G * 512) {
        const int e = i & 2047, v = (i >> 11) % 6, b = (i / (6 * 2048)) & 1, l = i / (2 * 6 * 2048);
        const int chunk = (v == 0) ? 1 : (v == 1) ? 0 : (v == 2) ? 2 : (v == 3) ? 4 : (v == 4) ? 3 : 5;
        const int j = chunk * 2048 + e;
        float s = a.in[4][(size_t)l * 12288 + j];
        for (int kc = 0; kc < 32; ++kc) s += MODP[((size_t)(l * 32 + kc) * 2 + b) * 12288 + j];
        float r;
        if (v == 0) r = a.in[5][l * DM + e] * (1.f + s);
        else if (v == 1) r = s;
        else if (v == 2) r = a.in[6][l * DM + e] * s;
        else if (v == 3) r = a.in[7][l * DM + e] * (1.f + s);
        else if (v == 4) r = s;
        else r = a.in[8][l * DM + e] * s;
        MODV[i] = r;
    }
    const float* B1P = (const float*)(ws_ + WS_B1P); float* B1 = (float*)(ws_ + WS_B1);
    for (int i = BID_ * 512 + tid; i < NL * 2 * 256; i += F.G * 512) { const int lk = i >> 8, j = i & 255; float s = 0.f;
        for (int kc = 0; kc < 64; ++kc) s += B1P[((size_t)lk * 64 + kc) * 256 + j];
        B1[i] = s; }
}

template <int KIND, bool SHADOW = false>
__device__ __forceinline__ void norm_phase(Frame& F, int l) {
    unsigned char* const ws_ = fresh(F.ws);
    const int tid = fresh_tid(), lane = tid & 63, wave = __builtin_amdgcn_readfirstlane(tid >> 6);
    const int gw = fresh_s(F.vcu) * NWAVES + wave, NGW = F.G * NWAVES;
    const int rpw = (MTOK + NGW - 1) / NGW;
    const float* MODV = (const float*)(ws_ + WS_MODV); const bf16_t* Y = (const bf16_t*)(ws_ + WS_Y); bf16_t* H = SHADOW ? (bf16_t*)(ws_ + WS_PROJ + (size_t)MTOK * DM * 4) : (bf16_t*)(ws_ + WS_H);
    bf16_t* XB = (bf16_t*)(ws_ + WS_Y + (size_t)MTOK * DM * 2);
    const bool in_f32 = (KIND == 0) || (KIND == 1 && l == 0), out_f32 = (KIND == 2 && l == NL - 1);
    int mend = (gw + 1) * rpw; if (mend > MTOK) mend = MTOK;
    const bool do_h = !(KIND == 2 && l == NL - 1);
    const int lv = (KIND == 2 && l + 1 < NL) ? l + 1 : l;
    f32x4 gv[8], av[8], sv[8]; int bcur = -1;
    f32x4 xf[8]; u32x2 xr2[8], yr2[8];
#define NP_LOAD(mm) do { if (in_f32) { const f32x4* xr = (const f32x4*)(F.x + (size_t)(mm) * DM) + lane; _Pragma("unroll") for (int j = 0; j < 8; ++j) xf[j] = xr[64 * j]; }              \
        else { const u32x2* xr = (const u32x2*)(XB + (size_t)(mm) * DM) + lane; _Pragma("unroll") for (int j = 0; j < 8; ++j) xr2[j] = xr[64 * j]; }                                       \
        if (KIND != 0) { const u32x2* yr = (const u32x2*)(Y + (size_t)(mm) * DM) + lane; _Pragma("unroll") for (int j = 0; j < 8; ++j) yr2[j] = yr[64 * j]; } } while (0)
    if (gw * rpw < mend) NP_LOAD(gw * rpw);
    for (int m = gw * rpw; m < mend; ++m) {
        const int b = m / SEQ;
        if (b != bcur) { bcur = b;
            const f32x4* gp = (const f32x4*)(MODV + ((size_t)(l * 2 + b) * 6 + (KIND == 1 ? 2 : 5)) * DM) + lane;
            const f32x4* ap = (const f32x4*)(MODV + ((size_t)(lv * 2 + b) * 6 + (KIND == 1 ? 3 : 0)) * DM) + lane;
            const f32x4* sp = (const f32x4*)(MODV + ((size_t)(lv * 2 + b) * 6 + (KIND == 1 ? 4 : 1)) * DM) + lane;
#pragma unroll
            for (int j = 0; j < 8; ++j) { if (KIND != 0) gv[j] = gp[64 * j]; av[j] = ap[64 * j]; sv[j] = sp[64 * j]; } }
        f32x4 xv[8], yv[8];
#pragma unroll
        for (int j = 0; j < 8; ++j) {
            if (in_f32) xv[j] = xf[j];
            else xv[j] = (f32x4){__builtin_bit_cast(float, xr2[j].x << 16), __builtin_bit_cast(float, xr2[j].x & 0xffff0000u), __builtin_bit_cast(float, xr2[j].y << 16), __builtin_bit_cast(float, xr2[j].y & 0xffff0000u)};
            if (KIND != 0) yv[j] = (f32x4){__builtin_bit_cast(float, yr2[j].x << 16), __builtin_bit_cast(float, yr2[j].x & 0xffff0000u), __builtin_bit_cast(float, yr2[j].y << 16), __builtin_bit_cast(float, yr2[j].y & 0xffff0000u)}; }
        if (m + 1 < mend) NP_LOAD(m + 1);
        if (KIND != 0) {
            float ss = 0.f;
#pragma unroll
            for (int j = 0; j < 8; ++j) ss += (yv[j].x * yv[j].x + yv[j].y * yv[j].y) + (yv[j].z * yv[j].z + yv[j].w * yv[j].w);
            const float rs = 1.f / sqrtf(wave_sum(ss) * (1.f / DM) + NORM_EPS);
#pragma unroll
            for (int j = 0; j < 8; ++j) xv[j] = xv[j] + (yv[j] * rs) * gv[j];
            if (out_f32) { f32x4* xo = (f32x4*)(F.out + (size_t)m * DM) + lane;
#pragma unroll
                for (int j = 0; j < 8; ++j) xo[64 * j] = xv[j]; }
            else { u32x2* xo = (u32x2*)(XB + (size_t)m * DM) + lane;
#pragma unroll
                for (int j = 0; j < 8; ++j) { u32x2 w; w.x = cvtpk(xv[j].x, xv[j].y); w.y = cvtpk(xv[j].z, xv[j].w); xo[64 * j] = w; } }
        }
        if (!do_h) continue;
        float ss = 0.f;
#pragma unroll
        for (int j = 0; j < 8; ++j) ss += (xv[j].x * xv[j].x + xv[j].y * xv[j].y) + (xv[j].z * xv[j].z + xv[j].w * xv[j].w);
        const float rs = 1.f / sqrtf(wave_sum(ss) * (1.f / DM) + NORM_EPS);
        u32x2* ho = (u32x2*)(H + (size_t)m * DM) + lane;
#pragma unroll
        for (int j = 0; j < 8; ++j) { const f32x4 hv = (xv[j] * rs) * av[j] + sv[j]; u32x2 w; w.x = cvtpk(hv.x, hv.y); w.y = cvtpk(hv.z, hv.w); ho[64 * j] = w; }
    }
#undef NP_LOAD
}

__device__ __forceinline__ void kmean_item(Frame& F, int it) {
    unsigned char* const ws_ = fresh(F.ws);
    const int BID_ = fresh_s((int)blockIdx.x); (void)BID_; const int tid = fresh_tid(), lane = tid & 63, wave = __builtin_amdgcn_readfirstlane(tid >> 6); (void)lane; (void)wave;
    const int blk = it & 31, bh = it >> 5, b = bh >> 2, h = bh & 3;
    const bf16_t* Kp = (const bf16_t*)(ws_ + WS_PROJ) + ((size_t)b * SEQ + blk * 256) * PW + C_MK + h * 128;
    LAS float* red = (LAS float*)F.lds;
    const int kq = tid >> 4, dc = (tid & 15) * 8;
    float acc[8] = {0.f, 0.f, 0.f, 0.f, 0.f, 0.f, 0.f, 0.f};
    for (int i = 0; i < 8; ++i) { const bf16x8 v = *(const bf16x8*)(Kp + (size_t)(kq * 8 + i) * PW + dc);
#pragma unroll
        for (int j = 0; j < 8; ++j) acc[j] += bf2f((unsigned short)v[j]); }
    __syncthreads();
#pragma unroll
    for (int j = 0; j < 8; ++j) red[kq * 128 + dc + j] = acc[j];
    __syncthreads();
    if (tid < 128) { float s = 0.f; for (int q = 0; q < 32; ++q) s += red[q * 128 + tid];
        ((float*)(ws_ + WS_KMEAN))[(size_t)it * 128 + tid] = s * (1.f / 256.f); }
}
__device__ __forceinline__ void cumsum_item(Frame& F, int bh) {
    unsigned char* const ws_ = fresh(F.ws);
    const int tid = fresh_tid(), lane = tid & 63, wave = __builtin_amdgcn_readfirstlane(tid >> 6);
    const int b = bh >> 3, h = bh & 7;
    const float* gf = (const float*)(ws_ + WS_GF) + (size_t)b * SEQ * 32 + 12 + h;
    LAS float* tot = (LAS float*)F.lds;
    float v[16];
#pragma unroll
    for (int i = 0; i < 16; ++i) v[i] = gf[(size_t)(tid * 16 + i) * 32];
#pragma unroll
    for (int i = 1; i < 16; ++i) v[i] += v[i - 1];
    float inc = v[15];
#pragma unroll
    for (int o = 1; o < 64; o <<= 1) { const float u = __shfl_up(inc, o); if (lane >= o) inc += u; }
    __syncthreads();
    if (lane == 63) tot[wave] = inc;
    __syncthreads();
    float off = inc - v[15];
    for (int w = 0; w < wave; ++w) off += tot[w];
    float* out = (float*)(ws_ + WS_CUMS) + (size_t)bh * SEQ + tid * 16;
    constexpr float INVS = 11.313708498984761f;
#pragma unroll
    for (int i = 0; i < 16; ++i) out[i] = (off + v[i]) * INVS;
    __syncthreads();
}
__device__ __forceinline__ void foxnorm_item(Frame& F, int it) {
    unsigned char* const ws_ = fresh(F.ws);
    const int tid = fresh_tid();
    const int qb = it & 31, bh = it >> 5, b = bh >> 3, h = bh & 7;
    const bf16_t* P = (const bf16_t*)(ws_ + WS_PROJ); const size_t m0 = (size_t)b * SEQ + qb * 256;
    LAS float* red = (LAS float*)F.lds;
    float kn = 0.f;
    if (tid < 256) {
        const bf16_t* qrow = P + (m0 + tid) * PW + C_FQ + h * 128; const bf16_t* krow = P + (m0 + tid) * PW + C_FK + h * 128;
        float qq = 0.f, kk = 0.f, qk = 0.f;
#pragma unroll
        for (int c = 0; c < 16; ++c) { const bf16x8 qv = *(const bf16x8*)(qrow + c * 8), kv = *(const bf16x8*)(krow + c * 8);
#pragma unroll
            for (int j = 0; j < 8; ++j) { const float a = bf2f((unsigned short)qv[j]), k = bf2f((unsigned short)kv[j]); qq = fmaf(a, a, qq); kk = fmaf(k, k, kk); qk = fmaf(a, k, qk); } }
        ((float*)(ws_ + WS_QN))[(size_t)bh * SEQ + qb * 256 + tid] = sqrtf(qq);
        ((float*)(ws_ + WS_DG))[(size_t)bh * SEQ + qb * 256 + tid] = qk * SM_SCALE;
        kn = sqrtf(kk);
    }
#pragma unroll
    for (int o = 1; o < 64; o <<= 1) kn = fmaxf(kn, __shfl_xor(kn, o));
    __syncthreads();
    if ((tid & 63) == 0) red[tid >> 6] = kn;
    __syncthreads();
    if (tid == 0) { float m = red[0]; for (int w = 1; w < 8; ++w) m = fmaxf(m, red[w]); ((float*)(ws_ + WS_KMX))[it] = m; }
    __syncthreads();
}
__device__ __forceinline__ void cmp_stage2_item(Frame& F, const Args& a, int l, int it) {
    unsigned char* const ws_ = fresh(F.ws);
    const int BID_ = fresh_s((int)blockIdx.x); (void)BID_; const int tid = fresh_tid(), lane = tid & 63, wave = __builtin_amdgcn_readfirstlane(tid >> 6); (void)lane; (void)wave;
    const int kv = it >> 7, r0 = (it & 127) * 8;
    const float* CP = (const float*)(ws_ + WS_CPART) + (size_t)kv * 16 * 1024 * 256; const float* B1 = (const float*)(ws_ + WS_B1) + (size_t)(l * 2 + kv) * 256;
    LAS float* h1 = (LAS float*)F.lds;
    const int row = tid >> 6, c4 = (tid & 63) * 4;
    f32x4 s = *(const f32x4*)(B1 + c4);
    for (int ks = 0; ks < 16; ++ks) s += *(const f32x4*)(CP + ((size_t)ks * 1024 + r0 + row) * 256 + c4);
    __syncthreads();
#pragma unroll
    for (int j = 0; j < 4; ++j) { const float x = s[j]; const float u = 0.7978845608028654f * (x + 0.044715f * x * x * x); h1[row * 256 + c4 + j] = 0.5f * x * (1.f + tanhf(u)); }
    __syncthreads();
    const int oc = (tid & 63) * 2, ks = __builtin_amdgcn_readfirstlane(tid >> 6); const float* w2 = a.in[kv ? 16 : 14] + ((size_t)l * 256 + ks * 32) * 128 + oc;
    f32x2 wv[32];
#pragma unroll
    for (int k = 0; k < 32; ++k) wv[k] = *(const f32x2*)(w2 + (size_t)k * 128);
    LAS float* part = h1 + 8 * 256;
#pragma unroll
    for (int r = 0; r < 8; ++r) { float p0 = 0.f, p1 = 0.f;
#pragma unroll
        for (int k4 = 0; k4 < 8; ++k4) { const f32x4 hv = *(const LAS f32x4*)(h1 + r * 256 + ks * 32 + k4 * 4);
            p0 += hv.x * wv[4 * k4].x + hv.y * wv[4 * k4 + 1].x + hv.z * wv[4 * k4 + 2].x + hv.w * wv[4 * k4 + 3].x;
            p1 += hv.x * wv[4 * k4].y + hv.y * wv[4 * k4 + 1].y + hv.z * wv[4 * k4 + 2].y + hv.w * wv[4 * k4 + 3].y; }
        *(LAS f32x2*)(part + (ks * 8 + r) * 128 + oc) = (f32x2){p0, p1}; }
    __syncthreads();
    float o0 = 0.f, o1 = 0.f;
#pragma unroll
    for (int s8 = 0; s8 < 8; ++s8) { const f32x2 pv = *(const LAS f32x2*)(part + (s8 * 8 + row) * 128 + oc); o0 += pv.x; o1 += pv.y; }
    const int gr = r0 + row;
    if ((gr & 511) == 511) { o0 = 0.f; o1 = 0.f; }
    bf16_t* dst = (bf16_t*)(ws_ + (kv ? WS_VCMP : WS_KCMP)) + (size_t)gr * 128 + oc;
    *(unsigned*)dst = cvtpk(o0, o1);
    __syncthreads();
}

__device__ __forceinline__ void fox_item(Frame& F, int b, int h, int qb) {
    unsigned char* const ws_ = fresh(F.ws);
    const int tid = fresh_tid(), lane = tid & 63, wave = __builtin_amdgcn_readfirstlane(tid >> 6);
    float* auxf = (float*)(F.ldsg + att::L_AUX); const int bh = b * 8 + h; const float* cs = (const float*)(ws_ + WS_CUMS) + (size_t)bh * SEQ;
    float* redf = (float*)(F.ldsg + att::L_BITS);
    int jlo, wjlo;
    {
        const float* kmx = (const float*)(ws_ + WS_KMX) + bh * 32;
        float kg = (lane <= qb) ? kmx[lane] : 0.f;
        float qn = 0.f, dg = 0.f;
        if (tid < 256) { qn = ((const float*)(ws_ + WS_QN))[(size_t)bh * SEQ + qb * 256 + tid]; dg = ((const float*)(ws_ + WS_DG))[(size_t)bh * SEQ + qb * 256 + tid]; }
        const float c0s = cs[qb * 256];
        const float c0 = c0s * SM_SCALE, c0w = cs[qb * 256 + 32 * wave] * SM_SCALE;
        const bool t0v = lane < 4 * qb, t1v = lane + 64 < 4 * qb;
        const float ce0 = cs[(t0v ? lane : 0) * 64 + 63] * SM_SCALE, ce1 = cs[(t1v ? lane + 64 : 0) * 64 + 63] * SM_SCALE;
        for (int i = tid; i < (qb + 1) * 64; i += 512) ((f32x4*)auxf)[i] = c0s - ((const f32x4*)cs)[i];
#pragma unroll
        for (int o = 1; o < 64; o <<= 1) kg = fmaxf(kg, __shfl_xor(kg, o));
        float a = (tid < 256) ? qn * kg * SM_SCALE - dg : -3e38f;
#pragma unroll
        for (int o = 1; o < 32; o <<= 1) a = fmaxf(a, __shfl_xor(a, o));
        if ((lane & 31) == 0 && tid < 256) redf[tid >> 5] = a;
        __syncthreads();
        const float Aw = redf[wave];
        float A = redf[0];
#pragma unroll
        for (int w = 1; w < 8; ++w) A = fmaxf(A, redf[w]);
        const bool k0_ = !t0v || (A + c0 - ce0) >= -FOX_T, w0_ = !t0v || (Aw + c0w - ce0) >= -FOX_T;
        const bool k1_ = !t1v || (A + c0 - ce1) >= -FOX_T, w1_ = !t1v || (Aw + c0w - ce1) >= -FOX_T;
        const unsigned long long km0 = __ballot(k0_), km1 = __ballot(k1_), wm0 = __ballot(w0_), wm1 = __ballot(w1_);
        jlo = km0 ? (int)__builtin_ctzll(km0) : 64 + (int)__builtin_ctzll(km1);
        wjlo = wm0 ? (int)__builtin_ctzll(wm0) : 64 + (int)__builtin_ctzll(wm1);
        if (jlo > 4 * qb) jlo = 4 * qb;
        if (wjlo > 4 * qb) wjlo = 4 * qb;
        jlo = __builtin_amdgcn_readfirstlane(jlo); wjlo = __builtin_amdgcn_readfirstlane(wjlo);
        __syncthreads();
    }
    const bf16_t* P = (const bf16_t*)(ws_ + WS_PROJ); const size_t m0 = (size_t)b * SEQ + qb * 256;
    att::Ref R{P + m0 * PW + C_FQ + h * 128, P + (size_t)b * SEQ * PW + C_FK + h * 128, P + (size_t)b * SEQ * PW + C_FV + h * 128, PW, qb * 256, SEQ, jlo};
    att::Out E{(bf16_t*)(ws_ + WS_O) + m0 * DM + O_FOX + h * 128, nullptr, nullptr, 0};
    bf16x8 qr[8]; float mo, lo;
    att::attn_pass<att::M_FOX, true>(R, F.ldsg, qr, E, mo, lo, (unsigned long long)wjlo, 0ull);
}
__device__ __forceinline__ void moba_gate_item(Frame& F, int l, int it) {
    unsigned char* const ws_ = fresh(F.ws);
    const int tid = fresh_tid();
    const int qb = it & 31, bh = it >> 5, b = bh >> 2, h = bh & 3;
    if (qb == 0) return;
    float* auxf = (float*)(F.ldsg + att::L_AUX);
    const bf16_t* P = (const bf16_t*)(ws_ + WS_PROJ); const size_t m0 = (size_t)b * SEQ + qb * 256;
    const float* km = (const float*)(ws_ + WS_KMEAN) + (size_t)bh * 32 * 128;
    const int row = tid >> 1, half = tid & 1;
    const bf16_t* qrow = P + (m0 + row) * PW + C_MQ + h * 128 + half * 64;
    bf16x8 qraw[8];
#pragma unroll
    for (int c = 0; c < 8; ++c) qraw[c] = *(const bf16x8*)(qrow + c * 8);
    __syncthreads();
    for (int i = tid; i < qb * 32; i += 512) ((f32x4*)auxf)[i] = ((const f32x4*)km)[i];
    __syncthreads();
    {
        f32x4 q[16];
#pragma unroll
        for (int c = 0; c < 8; ++c) { const bf16x8 v = qraw[c];
            q[2 * c] = (f32x4){bf2f((unsigned short)v[0]), bf2f((unsigned short)v[1]), bf2f((unsigned short)v[2]), bf2f((unsigned short)v[3])};
            q[2 * c + 1] = (f32x4){bf2f((unsigned short)v[4]), bf2f((unsigned short)v[5]), bf2f((unsigned short)v[6]), bf2f((unsigned short)v[7])}; }
        float b0 = -3e38f, b1 = -3e38f, b2 = -3e38f; int i0 = -1, i1 = -1, i2 = -1;
        for (int n = 0; n < qb; ++n) {
            const f32x4* kmr = (const f32x4*)(auxf + n * 128 + half * 64);
            f32x4 a4 = {0.f, 0.f, 0.f, 0.f};
#pragma unroll
            for (int c = 0; c < 16; ++c) a4 += q[c] * kmr[c];
            float g = (a4.x + a4.y) + (a4.z + a4.w);
            g += __shfl_xor(g, 1);
            if (g > b0) { b2 = b1; i2 = i1; b1 = b0; i1 = i0; b0 = g; i0 = n; }
            else if (g > b1) { b2 = b1; i2 = i1; b1 = g; i1 = n; }
            else if (g > b2) { b2 = g; i2 = n; }
        }
        unsigned* lc = (unsigned*)(F.ldsg + att::L_BITS);
        __syncthreads();
        if (tid < 64) lc[tid] = 0u;
        __syncthreads();
        unsigned r0 = 0, r1 = 0, r2 = 0;
        if (half == 0) { if (i0 >= 0) r0 = atomicAdd(&lc[i0], 1u); if (i1 >= 0) r1 = atomicAdd(&lc[i1], 1u); if (i2 >= 0) r2 = atomicAdd(&lc[i2], 1u); }
        __syncthreads();
        if (tid < qb) { const unsigned c = lc[tid]; lc[32 + tid] = c ? __hip_atomic_fetch_add(F.ctl + CW_MC + ((l * 8 + bh) * 32 + tid) * 64, c, RLX_AGENT) : 0u; }
        __syncthreads();
        if (half == 0) {
            unsigned* lst = (unsigned*)(ws_ + WS_MLIST) + (size_t)bh * 32 * 8192;
            const unsigned tok = (unsigned)(qb * 256 + row);
            if (i0 >= 0) lst[(size_t)i0 * 8192 + lc[32 + i0] + r0] = tok;
            if (i1 >= 0) lst[(size_t)i1 * 8192 + lc[32 + i1] + r1] = tok | (1u << 16);
            if (i2 >= 0) lst[(size_t)i2 * 8192 + lc[32 + i2] + r2] = tok | (2u << 16);
        }
    }
}
__device__ __forceinline__ void moba_blk_item(Frame& F, int l, int bh, int j, bool own) {
    unsigned char* const ws_ = fresh(F.ws);
    const int b = bh >> 2, h = bh & 3;
    const bf16_t* P = (const bf16_t*)(ws_ + WS_PROJ) + (size_t)b * SEQ * PW;
    att::moba_block_load(P + (size_t)j * 256 * PW + C_MK + h * 128, P + (size_t)j * 256 * PW + C_MV + h * 128, F.ldsg);
    bf16_t* part = (bf16_t*)(ws_ + WS_MPART) + (size_t)bh * 8192 * 4 * 128; float* stat = (float*)(ws_ + WS_MSTAT) + (size_t)bh * 8192 * 4 * 2;
    if (own) att::moba_block_groups<true>(P + C_MQ + h * 128, nullptr, 256, j, part, stat, F.ldsg);
    else { const int cnt = __builtin_amdgcn_readfirstlane((int)__hip_atomic_load(F.ctl + CW_MC + (l * 256 + bh * 32 + j) * 64, RLX_AGENT));
        att::moba_block_groups<false>(P + C_MQ + h * 128, (const unsigned*)(ws_ + WS_MLIST) + ((size_t)bh * 32 + j) * 8192, cnt, j, part, stat, F.ldsg); }
}
__device__ __forceinline__ void moba_combine(Frame& F) {
    unsigned char* const ws_ = fresh(F.ws);
    const int tid = fresh_tid();
    const int BID_ = fresh_s((int)blockIdx.x);
    const bf16_t* part = (const bf16_t*)(ws_ + WS_MPART); const float* stat = (const float*)(ws_ + WS_MSTAT); bf16_t* O = (bf16_t*)(ws_ + WS_O);
    constexpr float C2 = 1.4426950408889634f * SM_SCALE;
    const int c8 = (tid & 15) * 8; const int rstep = F.G * 32; int row = BID_ * 32 + (tid >> 4);
    f32x4 sa, sb; bf16x8 pv[4];
#define MC_LOAD(r_) do { const float* st_ = stat + (size_t)(r_) * 8; sa = *(const f32x4*)st_; sb = *(const f32x4*)(st_ + 4);                                   \
        _Pragma("unroll") for (int k = 0; k < 4; ++k) pv[k] = *(const bf16x8*)(part + ((size_t)(r_) * 4 + k) * 128 + c8); } while (0)
    if (row < 8 * 8192) MC_LOAD(row);
    for (; row < 8 * 8192; row += rstep) {
        const int bh = row >> 13, t = row & 8191, b = bh >> 2, h = bh & 3;
        const int nsel = (t >> 8) < 3 ? (t >> 8) : 3;
        const float st[8] = {sa.x, sa.y, sa.z, sa.w, sb.x, sb.y, sb.z, sb.w};
        bf16x8 v4[4];
#pragma unroll
        for (int k = 0; k < 4; ++k) v4[k] = pv[k];
        if (row + rstep < 8 * 8192) MC_LOAD(row + rstep);
        float m[4], lw[4]; float M = st[6];
#pragma unroll
        for (int k = 0; k < 3; ++k) { m[k] = (k < nsel) ? st[2 * k] : -3e38f; lw[k] = (k < nsel) ? st[2 * k + 1] : 0.f; M = fmaxf(M, m[k]); }
        m[3] = st[6]; lw[3] = st[7];
        float acc[8] = {0.f, 0.f, 0.f, 0.f, 0.f, 0.f, 0.f, 0.f}; float den = 0.f;
#pragma unroll
        for (int k = 0; k < 4; ++k) { if (k < 3 && k >= nsel) continue;
            const float w = lw[k] * __builtin_amdgcn_exp2f((m[k] - M) * C2); den += w;
            const bf16x8 v = v4[k];
#pragma unroll
            for (int jj = 0; jj < 8; ++jj) acc[jj] = fmaf(w, bf2f((unsigned short)v[jj]), acc[jj]); }
        const float inv = 1.f / den;
        u32x4 w4; w4.x = cvtpk(acc[0] * inv, acc[1] * inv); w4.y = cvtpk(acc[2] * inv, acc[3] * inv); w4.z = cvtpk(acc[4] * inv, acc[5] * inv); w4.w = cvtpk(acc[6] * inv, acc[7] * inv);
        *(u32x4*)(O + ((size_t)b * SEQ + t) * DM + O_MOBA + h * 128 + c8) = w4;
    }
#undef MC_LOAD
}
__device__ __forceinline__ void nsa_item(Frame& F, int b, int tb) {
    unsigned char* const ws_ = fresh(F.ws);
    const int BID_ = fresh_s((int)blockIdx.x); (void)BID_; const int tid = fresh_tid(), lane = tid & 63, wave = __builtin_amdgcn_readfirstlane(tid >> 6); (void)lane; (void)wave;
    float* imp = (float*)(F.ldsg + att::L_AUX); unsigned* bits = (unsigned*)(F.ldsg + att::L_BITS);
    const bf16_t* P = (const bf16_t*)(ws_ + WS_PROJ); const int P0 = tb * 64; const size_t m0 = (size_t)b * SEQ + P0;
    { float z = 0.f; asm volatile("" : "+v"(z)); const f32x4 zz = {z, z, z, z};
      for (int i = tid; i < 2048; i += 512) ((f32x4*)imp)[i] = zz; }
    __syncthreads();
    float* scr = (float*)(ws_ + WS_SCR) + (size_t)BID_ * 2 * 256 * 128;
    const float* gf = (const float*)(ws_ + WS_GF) + m0 * 32;
    bf16_t* Ob = (bf16_t*)(ws_ + WS_O) + m0 * DM + O_NSA;
    const bf16_t* Kc = (const bf16_t*)(ws_ + WS_KCMP) + (size_t)b * 512 * 128; const bf16_t* Vc = (const bf16_t*)(ws_ + WS_VCMP) + (size_t)b * 512 * 128;
    bf16x8 qr[8]; float mo, lo;
    {
        att::Ref R{P + m0 * PW + C_NQ, Kc, Vc, 128, P0, NCMPP, 0};
        att::Out E{Ob, scr, gf, 0};
        att::attn_pass<att::M_CMP, true>(R, F.ldsg, qr, E, mo, lo, 0ull, 0ull);
        att::cmp_imp_pass(Kc, P0, F.ldsg, qr, mo, lo);
    }
    {
        const int cur = tb, nforced = cur == 0 ? 1 : (cur == 1 ? 2 : 3), nrest = 16 - nforced;
        const int n0 = lane, n1 = lane + 64;
        const bool cand0 = (n0 >= 1 && n0 <= cur - 2), cand1 = (n1 <= cur - 2);
        const bool f0 = (n0 == 0 || n0 == cur || n0 == cur - 1), f1 = (n1 == cur || n1 == cur - 1);
        for (int q = 0; q < 8; q += 2) {
            const int tka = 8 * wave + q, tkb = tka + 1; const float* ira = imp + tka * 128; const float* irb = imp + tkb * 128;
            const unsigned ba0 = __float_as_uint(ira[lane]), ba1 = __float_as_uint(ira[lane + 64]), bb0 = __float_as_uint(irb[lane]), bb1 = __float_as_uint(irb[lane + 64]);
            const unsigned ka0 = cand0 ? ba0 : 0u, ka1 = cand1 ? ba1 : 0u, kb0 = cand0 ? bb0 : 0u, kb1 = cand1 ? bb1 : 0u;
            unsigned Ta = 0u, Tb = 0u;
#pragma unroll 1
            for (int b = 30; b >= 0; --b) {
                const unsigned ta = Ta | (1u << b), tb2 = Tb | (1u << b);
                const int ca = __builtin_popcountll(__ballot(ka0 >= ta)) + __builtin_popcountll(__ballot(ka1 >= ta));
                const int cb = __builtin_popcountll(__ballot(kb0 >= tb2)) + __builtin_popcountll(__ballot(kb1 >= tb2));
                if (ca >= nrest) Ta = ta;
                if (cb >= nrest) Tb = tb2;
            }
#define NSA_PICK(T_, k0_, k1_, tk_) do {                                                                                          \
                const bool g0 = (k0_) > (T_), g1 = (k1_) > (T_);                                                                  \
                const int need = nrest - (__builtin_popcountll(__ballot(g0)) + __builtin_popcountll(__ballot(g1)));               \
                const bool e0 = cand0 && (k0_) == (T_), e1 = cand1 && (k1_) == (T_);                                              \
                const unsigned long long me0 = __ballot(e0), me1 = __ballot(e1);                                                  \
                const int rk0 = (int)__builtin_amdgcn_mbcnt_hi((unsigned)(me0 >> 32), __builtin_amdgcn_mbcnt_lo((unsigned)me0, 0u));   \
                const int rk1 = __builtin_popcountll(me0) + (int)__builtin_amdgcn_mbcnt_hi((unsigned)(me1 >> 32), __builtin_amdgcn_mbcnt_lo((unsigned)me1, 0u)); \
                const bool s0 = n0 <= cur && (f0 || g0 || (e0 && rk0 < need)), s1 = n1 <= cur && (f1 || g1 || (e1 && rk1 < need));  \
                const unsigned long long m0b = __ballot(s0), m1b = __ballot(s1);                                                  \
                if (lane == 0) { bits[(tk_) * 4 + 0] = (unsigned)m0b; bits[(tk_) * 4 + 1] = (unsigned)(m0b >> 32); bits[(tk_) * 4 + 2] = (unsigned)m1b; bits[(tk_) * 4 + 3] = (unsigned)(m1b >> 32); } } while (0)
            NSA_PICK(Ta, ka0, ka1, tka); NSA_PICK(Tb, kb0, kb1, tkb);
#undef NSA_PICK
#if TOPK_CHECK
            for (int w2 = 0; w2 < 2; ++w2) { const int tk = w2 ? tkb : tka; const float* ir = imp + tk * 128;
                const float v0 = ir[lane], v1 = ir[lane + 64]; int r0 = 0, r1 = 0;
                for (int m = 1; m <= cur - 2; ++m) { const float xv = ir[m];
                    r0 += (xv > v0 || (xv == v0 && m < lane)) ? 1 : 0; r1 += (xv > v1 || (xv == v1 && m < lane + 64)) ? 1 : 0; }
                const bool s0 = n0 <= cur && (f0 || r0 < nrest), s1 = n1 <= cur && (f1 || r1 < nrest);
                const unsigned long long m0b = __ballot(s0), m1b = __ballot(s1);
                asm volatile("s_waitcnt lgkmcnt(0)" ::: "memory");
                if (lane == 0 && (bits[tk * 4 + 0] != (unsigned)m0b || bits[tk * 4 + 1] != (unsigned)(m0b >> 32) || bits[tk * 4 + 2] != (unsigned)m1b || bits[tk * 4 + 3] != (unsigned)(m1b >> 32))) F.MISC[20] = 1u; }
#endif
        }
        __syncthreads();
    }
    unsigned long long wlo, whi;
    {
        unsigned v = (lane < 32) ? bits[(8 * wave + (lane >> 2)) * 4 + (lane & 3)] : 0u;
        v |= __shfl_xor(v, 4); v |= __shfl_xor(v, 8); v |= __shfl_xor(v, 16);
        const unsigned w0 = __builtin_amdgcn_readlane(v, 0), w1 = __builtin_amdgcn_readlane(v, 1), w2 = __builtin_amdgcn_readlane(v, 2), w3 = __builtin_amdgcn_readlane(v, 3);
        wlo = (unsigned long long)w0 | ((unsigned long long)w1 << 32); whi = (unsigned long long)w2 | ((unsigned long long)w3 << 32);
    }
    {
        att::Ref R{P + m0 * PW + C_NQ, P + (size_t)b * SEQ * PW + C_KS, P + (size_t)b * SEQ * PW + C_VS, PW, P0, SEQ, 0};
        att::Out E{Ob, scr, gf, 1};
        att::attn_pass<att::M_SEL, false>(R, F.ldsg, qr, E, mo, lo, wlo, whi);
    }
    {
        att::Ref R{P + m0 * PW + C_NQ, P + (size_t)b * SEQ * PW + C_KW, P + (size_t)b * SEQ * PW + C_VW, PW, P0, SEQ, 0};
        att::Out E{Ob, scr, gf, 2};
        att::attn_pass<att::M_WIN, false>(R, F.ldsg, qr, E, mo, lo, 0ull, 0ull);
    }
#if TOPK_CHECK
    __syncthreads(); if (F.MISC[20] != 0u && tid == 0) { asm volatile("s_waitcnt vmcnt(0)" ::: "memory"); Ob[0] = (bf16_t)0x7fc0; }
#endif
}
#ifndef EN_G4
#define EN_G4 1
#endif
#ifndef EN_G6
#define EN_G6 1
#endif
#ifndef EN_G7
#define EN_G7 1
#endif
#ifndef WGM_PROJ
#define WGM_PROJ 4
#endif
#ifndef WGM_OUT
#define WGM_OUT 4
#endif
#ifndef WGM_UP
#define WGM_UP 8
#endif
#ifndef WGM_DOWN
#define WGM_DOWN 4
#endif
#ifndef REP_ATT
#define REP_ATT 1
#endif
#ifndef REP_G3
#define REP_G3 1
#endif
#ifndef REP_PRO
#define REP_PRO 1
#endif
#ifndef REP_NORM
#define REP_NORM 1
#endif
#ifndef REP_BAR
#define REP_BAR 1
#endif
#ifndef REP_PRE
#define REP_PRE 1
#endif
#ifndef REP_FOX
#define REP_FOX 1
#endif
#ifndef REP_NSA
#define REP_NSA 1
#endif
#ifndef REP_UP
#define REP_UP 1
#endif
#ifndef EN_PRO
#define EN_PRO 1
#endif
#ifndef EN_NORM
#define EN_NORM 1
#endif
#ifndef EN_PROJ
#define EN_PROJ 1
#endif
#ifndef EN_PRE
#define EN_PRE 1
#endif
#ifndef EN_ATT
#define EN_ATT 1
#endif
#ifndef EN_GEMM
#define EN_GEMM 1
#endif
#ifndef EN_FOX
#define EN_FOX 1
#endif
#ifndef EN_MOBA
#define EN_MOBA 1
#endif
#ifndef EN_NSA
#define EN_NSA 1
#endif

__global__ void __launch_bounds__(NWAVES * 64, 2) mega_fwd(Args args) {
    extern __shared__ __attribute__((aligned(16))) unsigned char lds[];
    Frame F;
    F.lds = (LAS unsigned char*)lds; F.ldsg = (char*)lds;
    F.MISC = (volatile LAS unsigned*)(F.lds + MISC_OFF);
    F.G = gridDim.x; { const int bx = blockIdx.x; F.vcu = (F.G % 8 == 0) ? (bx % 8) * (F.G / 8) + bx / 8 : bx; }
    F.ws = args.ws; F.ctl = (gu32*)(args.ws + WS_CTL); F.x = args.in[0]; F.out = args.out;
    for (int u = threadIdx.x; u < (LDS_BYTES - LDSCTL_OFF) / 4; u += NWAVES * 64) ((LAS unsigned*)(F.lds + LDSCTL_OFF))[u] = 0u;
    __syncthreads();
    XcdBarrier bar; bar.bar = (unsigned*)(F.ctl + CW_BAR); bar.x = 0; bar.st = nullptr;
    if (args.use_bar) bar = xcd_barrier_post((unsigned*)(F.ctl + CW_BAR), F.MISC + 8);
    const int lo = args.ph_lo, hi = args.ph_hi;
#define IN(k) (lo <= (k) && (k) < hi)
#define SEAM(k) do { if (IN(k) && IN((k) + 1)) { xcd_barrier(bar); if (REP_BAR > 1) xcd_barrier(bar); } } while (0)

    if (EN_PRO && IN(0)) { prologue_a(F, args); if (REP_PRO > 1) { __syncthreads(); prologue_a(F, args); } } SEAM(0);
    if (EN_PRO && IN(1)) { prologue_b(F, args); } SEAM(1);
    if (EN_NORM && IN(2)) { norm_phase<0>(F, 0); } SEAM(2);

    for (int l = 0; l < NL; ++l) {
        const int pb = N_PRO + PH_PER_LAYER * l;
#define WSF fresh(F.ws)
        if (EN_PROJ && IN(pb + 0)) { unsigned char* const wsl = fresh(F.ws); const int bid = fresh_s((int)blockIdx.x); (void)bid;
            pg8::Gemm g{(const bf16_t*)(wsl + WS_H), (const bf16_t*)(wsl + WS_WIN) + (size_t)l * NPROJ * DM, DM, DM, DM};
            pg8::StaticOrder S; S.init(MTOK, NPROJ, F.G, bid, WGM_PROJ);
            pg8::EpiProj E{(bf16_t*)(wsl + WS_PROJ), (bf16_t*)(wsl + WS_KC), (bf16_t*)(wsl + WS_VC), (float*)(wsl + WS_GF), (const _Float16*)(wsl + WS_CS), args.in[10] + l * 8};
            S.rep = REP_G3; pg8::gemm_phase<pg8::EpiProj, pg8::StaticOrder, true, true>(F.lds, g, S, E);
        }
        SEAM(pb + 0);
        if (EN_PRE && IN(pb + 1)) { unsigned char* const wsl = fresh(F.ws); const int bid = fresh_s((int)blockIdx.x); (void)bid;
            for (int rep_ = 0; rep_ < REP_PRE; ++rep_) {
            if (bid < 128) {
                pg8::Gemm g{(const bf16_t*)(wsl + WS_KC), (const bf16_t*)(wsl + WS_W1T) + (size_t)l * 2 * 256 * 4096, 2048, 4096, 256};
                pg8::CmpOrder S{128, bid, WS_VC - WS_KC, (size_t)256 * 4096 * 2};
                pg8::EpiPart E{(float*)(wsl + WS_CPART)};
                pg8::gemm_phase<pg8::EpiPart, pg8::CmpOrder, false, true>(F.lds, g, S, E);
            }
            for (int it = (bid + 128) % F.G; it < 784; it += F.G) {
                if (it < 16) cumsum_item(F, it);
                else if (it < 272) kmean_item(F, it - 16);
                else foxnorm_item(F, it - 272);
            }
                    }
        }
        SEAM(pb + 1);
        if (EN_PRE && IN(pb + 2)) { unsigned char* const wsl = fresh(F.ws); const int bid = fresh_s((int)blockIdx.x); (void)bid; (void)wsl;
            for (int rep_ = 0; rep_ < REP_PRE; ++rep_) for (int it = bid; it < 256; it += F.G) cmp_stage2_item(F, args, l, it);
            for (int it = bid; it < 256; it += F.G) moba_gate_item(F, l, it);
        }
        SEAM(pb + 2);
        if (EN_ATT && IN(pb + 3)) { unsigned char* const wsl = fresh(F.ws); (void)wsl;
            gu32* head = F.ctl + CW_Q + 64 * l;
            for (;;) {
                __syncthreads();
                if (threadIdx.x == 0) F.MISC[16] = __hip_atomic_fetch_add(head, 1u, RLX_AGENT);
                __syncthreads();
                const int idx0 = __builtin_amdgcn_readfirstlane((int)F.MISC[16]);
                const int nconv = (l + 1 < NL) ? W_ITEMS_LAYER / 8 : 0;
                if (idx0 >= 1280 * REP_ATT + nconv) break;
                if (idx0 >= 1280 * REP_ATT) {
                    const int tid_ = fresh_tid(), wv_ = __builtin_amdgcn_readfirstlane(tid_ >> 6);
                    weight_item(fresh(F.ws), args, l + 1, (idx0 - 1280 * REP_ATT) * 8 + wv_, (LAS float*)(F.lds + wv_ * 16384), tid_ & 63);
                    continue;
                }
                const int idx = idx0 % 1280;
                if (idx < 1024) {
                    const int q = idx >> 5, s_ = idx & 31, qb = 31 - q;
                    if (s_ < 16) { if (EN_FOX) { fox_item(F, s_ >> 3, s_ & 7, qb); if (REP_FOX > 1) fox_item(F, s_ >> 3, s_ & 7, qb); } }
                    else if (s_ < 24) { if (EN_NSA) { nsa_item(F, (s_ - 16) >> 2, 4 * qb + 3 - ((s_ - 16) & 3)); if (REP_NSA > 1) nsa_item(F, (s_ - 16) >> 2, 4 * qb + 3 - ((s_ - 16) & 3)); } }
                    else if (q < 31) { if (EN_MOBA) moba_blk_item(F, l, s_ - 24, q, false); }
                } else { if (EN_MOBA) moba_blk_item(F, l, (idx - 1024) >> 5, (idx - 1024) & 31, true); }
            }
        }
        SEAM(pb + 3);
        if (EN_ATT && IN(pb + 4)) { moba_combine(F); }
        SEAM(pb + 4);
        if (EN_GEMM && EN_G4 && IN(pb + 5)) { unsigned char* const wsl = fresh(F.ws); const int bid = fresh_s((int)blockIdx.x); (void)bid;
            pg8::Gemm g{(const bf16_t*)(wsl + WS_O), (const bf16_t*)(wsl + WS_WOUT) + (size_t)l * DM * DM, DM, DM, DM};
            pg8::StaticOrder S; S.init(MTOK, DM, F.G, bid, WGM_OUT);
            pg8::EpiBf16<0> E{(bf16_t*)(wsl + WS_Y), DM};
            S.rep = REP_G3; pg8::gemm_phase<pg8::EpiBf16<0>, pg8::StaticOrder, true, true>(F.lds, g, S, E);
        }
        SEAM(pb + 5);
        if (EN_NORM && IN(pb + 6)) { unsigned char* const wsl = fresh(F.ws); const int bid = fresh_s((int)blockIdx.x); (void)bid; norm_phase<1>(F, l); }
        SEAM(pb + 6);
        if (EN_GEMM && EN_G6 && IN(pb + 7)) { unsigned char* const wsl = fresh(F.ws); const int bid = fresh_s((int)blockIdx.x); (void)bid;
            pg8::Gemm g{(const bf16_t*)(wsl + WS_H), (const bf16_t*)(wsl + WS_WUP) + (size_t)l * FF * DM, DM, DM, DM};
            pg8::StaticOrder S; S.init(MTOK, FF, F.G, bid, WGM_UP);
            pg8::EpiBf16<1> E{(bf16_t*)(wsl + WS_U), FF};
            S.rep = REP_UP; pg8::gemm_phase<pg8::EpiBf16<1>, pg8::StaticOrder, true, true>(F.lds, g, S, E);
        }
        SEAM(pb + 7);
        if (EN_GEMM && EN_G7 && IN(pb + 8)) { unsigned char* const wsl = fresh(F.ws); const int bid = fresh_s((int)blockIdx.x); (void)bid;
            pg8::Gemm g{(const bf16_t*)(wsl + WS_U), (const bf16_t*)(wsl + WS_WDN) + (size_t)l * DM * FF, FF, FF, FF};
            pg8::StaticOrder S; S.init(MTOK, DM, F.G, bid, WGM_DOWN);
            pg8::EpiBf16<0> E{(bf16_t*)(wsl + WS_Y), DM};
            S.rep = REP_G3; pg8::gemm_phase<pg8::EpiBf16<0>, pg8::StaticOrder, true, true>(F.lds, g, S, E);
        }
        SEAM(pb + 8);
        if (EN_NORM && IN(pb + 9)) { unsigned char* const wsl = fresh(F.ws); const int bid = fresh_s((int)blockIdx.x); (void)bid; norm_phase<2>(F, l); }
        if (l + 1 < NL) SEAM(pb + 9);
    }
#undef IN
#undef SEAM
}

extern "C" void kernel_launch(void* const* d_in, const int* in_sizes, int n_in, void* d_out, int out_size, void* d_ws, size_t ws_size, hipStream_t stream) {
    static int grid = 0;
    if (grid == 0) {
        if (n_in != 20 || out_size != MTOK * DM || ws_size < WS_END) { fprintf(stderr, "kernel_launch: unexpected shapes (n_in %d, out %d, ws %zu, need %zu)\n", n_in, out_size, ws_size, (size_t)WS_END); grid = -1; return; }
        int dev = 0, cus = 0, per_cu = 0;
        if (hipGetDevice(&dev) != hipSuccess || hipDeviceGetAttribute(&cus, hipDeviceAttributeMultiprocessorCount, dev) != hipSuccess) { grid = -1; return; }
        if (hipFuncSetAttribute((const void*)mega_fwd, hipFuncAttributeMaxDynamicSharedMemorySize, LDS_BYTES) != hipSuccess) { fprintf(stderr, "kernel_launch: hipFuncSetAttribute failed\n"); grid = -1; return; }
        if (hipOccupancyMaxActiveBlocksPerMultiprocessor(&per_cu, (const void*)mega_fwd, NWAVES * 64, LDS_BYTES) != hipSuccess || per_cu < 1)
            fprintf(stderr, "kernel_launch: occupancy query reports %d workgroups per CU\n", per_cu);
        (void)hipGetLastError();
        grid = cus < 256 ? cus : 256;
        if (grid != 256) fprintf(stderr, "kernel_launch: %d CUs; this kernel is laid out for 256\n", grid);
    }
    if (grid < 0) return;
    (void)hipMemsetAsync((char*)d_ws + WS_CTL, 0, CTL_ZERO_BYTES, stream);
    Args a{};
    for (int i = 0; i < 20; ++i) a.in[i] = (const float*)d_in[i];
    a.out = (float*)d_out; a.ws = (unsigned char*)d_ws; a.pad = 0;
#if MK_SINGLE
    a.ph_lo = 0; a.ph_hi = N_PHASES; a.use_bar = 1;
    hipLaunchKernelGGL(mega_fwd, dim3(grid), dim3(NWAVES * 64), LDS_BYTES, stream, a);
#else
    for (int p = 0; p < N_PHASES; ++p) { a.ph_lo = p; a.ph_hi = p + 1; a.use_bar = 0;
        hipLaunchKernelGGL(mega_fwd, dim3(grid), dim3(NWAVES * 64), LDS_BYTES, stream, a); }
#endif
}
```

```cpp
#include <hip/hip_runtime.h>
#include <cstdio>
#include <cstdint>

#define GAS __attribute__((address_space(1)))
#define LAS __attribute__((address_space(3)))
typedef unsigned short bf16_t;
typedef short bf16x8 __attribute__((ext_vector_type(8)));
typedef short s16x4 __attribute__((ext_vector_type(4)));
typedef float f32x2 __attribute__((ext_vector_type(2)));
typedef float f32x4 __attribute__((ext_vector_type(4)));
typedef float f32x16 __attribute__((ext_vector_type(16)));
typedef unsigned u32x2 __attribute__((ext_vector_type(2)));
typedef unsigned u32x4 __attribute__((ext_vector_type(4)));
typedef GAS unsigned gu32;

constexpr int NB = 2, SEQ = 8192, DM = 2048, NL = 4, MTOK = NB * SEQ;
constexpr int HD = 128;
constexpr int PROJ_DIM = 5908, NPROJ = 6144, PW = 5888;
constexpr int FF = 8192;
constexpr int NCMP = 511, NCMPP = 512;
constexpr float NORM_EPS = 1e-6f;
constexpr float SM_SCALE = 0.08838834764831845f;
constexpr int C_MQ = 0, C_MK = 512, C_MV = 1024, C_NQ = 1536, C_KS = 2304, C_VS = 2432, C_KW = 2560, C_VW = 2688, C_FQ = 2816, C_FK = 3840, C_FV = 4864;
constexpr int O_MOBA = 0, O_NSA = 512, O_FOX = 1024;

#define LDS_WAIT() asm volatile("s_waitcnt lgkmcnt(0)" ::: "memory")
#define VM_WAIT() asm volatile("s_waitcnt vmcnt(0)" ::: "memory")
#define RLX_AGENT __ATOMIC_RELAXED, __HIP_MEMORY_SCOPE_AGENT
__device__ __forceinline__ unsigned f2bf(float f) { unsigned u = __builtin_bit_cast(unsigned, f); return (u + 0x7fffu + ((u >> 16) & 1u)) >> 16; }
__device__ __forceinline__ unsigned pk2(float lo, float hi) { return f2bf(lo) | (f2bf(hi) << 16); }
__device__ __forceinline__ float bf2f(unsigned short b) { return __builtin_bit_cast(float, ((unsigned)b) << 16); }
__device__ __forceinline__ unsigned cvtpk(float lo, float hi) { unsigned r; asm volatile("v_cvt_pk_bf16_f32 %0, %1, %2" : "=v"(r) : "v"(lo), "v"(hi)); return r; }
__device__ __forceinline__ float wave_sum(float v) {
#pragma unroll
    for (int o = 1; o < 64; o <<= 1) v += __shfl_xor(v, o);
    return v;
}

namespace pg8 {
#define PG8_LAS __attribute__((address_space(3)))
constexpr int BM = 256, BK = 64, HALF = 128, HTB = HALF * BK * 2  , STAGE_BYTES = 8 * HTB, NXCD = 8, WGM = 4;

__host__ __device__ __forceinline__ int lds_byte(int r, int c) { const int st = (r >> 4) * 2 + (c >> 5), rr = r & 15, cc = c & 31, ob = rr * 64 + cc * 2; return st * 1024 + (ob ^ (((ob >> 9) & 1) << 5)); }
__host__ __device__ __forceinline__ void stage_rc(int b, int& R, int& C) { const int st = b / 1024, sb = b % 1024, swz = sb ^ (((sb >> 9) & 1) << 5); R = (st >> 1) * 16 + swz / 64; C = (st & 1) * 32 + (swz % 64) / 2; }
__host__ __device__ __forceinline__ int perm32(int rho) { const int n = rho >> 4, i = rho & 15; return 8 * (i >> 2) + 4 * n + (i & 3); }

struct Unit { int pm, pn, aux; };
struct Gemm { const bf16_t* A; const bf16_t* Bt; int lda, ldb, K; };

struct StaticOrder {
    int nM, nN, nwg, G, c, rep, rev;
    __host__ __device__ void init(int M, int N, int G_, int c_, int rev_ = 0) { nM = M / BM; nN = N / BM; nwg = nM * nN; G = G_; c = c_; rep = 1; rev = rev_; }
    __host__ __device__ bool next(int i, Unit& u) const {
        const long L = (long)i * G + c; if (L >= (long)nwg * rep) return false;
        int wgid = (int)(L % nwg); { const int q = nwg / NXCD, r = nwg % NXCD, xcd = wgid % NXCD; int off = wgid / NXCD; if (rev && r == 0) off = q - 1 - off; wgid = (xcd < r ? xcd * (q + 1) : r * (q + 1) + (xcd - r) * q) + off; }
        const int nig = WGM * nN, gid = wgid / nig, fm = gid * WGM, gsz = (nM - fm) < WGM ? (nM - fm) : WGM;
        u.pm = fm + ((wgid % nig) % gsz); u.pn = (wgid % nig) / gsz; u.aux = 0; return true;
    }
    __device__ __forceinline__ size_t a_off(const Unit& u, const Gemm& g) const { return (size_t)u.pm * BM * g.lda * 2; }
    __device__ __forceinline__ size_t b_off(const Unit& u, const Gemm& g) const { return (size_t)u.pn * BM * g.ldb * 2; }
    __device__ __forceinline__ void a_ready(const Unit&) const {}
    __device__ __forceinline__ void done(const Unit&) const {}
};
struct CmpOrder {
    int G, c; size_t a_sel, b_sel;
    __device__ bool next(int i, Unit& u) const { const int L = i * G + c; if (L >= 128) return false; u.pm = L & 3; u.pn = 0; u.aux = L >> 2; return true; }
    __device__ __forceinline__ size_t a_off(const Unit& u, const Gemm& g) const { return (size_t)(u.aux >> 4) * a_sel + (size_t)u.pm * BM * g.lda * 2 + (size_t)(u.aux & 15) * 256 * 2; }
    __device__ __forceinline__ size_t b_off(const Unit& u, const Gemm& g) const { return (size_t)(u.aux >> 4) * b_sel + (size_t)(u.aux & 15) * 256 * 2; }
    __device__ __forceinline__ void a_ready(const Unit&) const {}
    __device__ __forceinline__ void done(const Unit&) const {}
};

struct EpiF32 {
    static constexpr bool PERM = false, AFTER_DRAIN = false, LDS_TABLE = false;
    float* C; int ldc;
    __device__ __forceinline__ void operator()(const f32x4 (&acc)[2][2][4][2], const Unit& u, int wr, int wc, int fr, int fq) const {
        const int row0 = u.pm * BM + wr * 64 + fr, col0 = u.pn * BM + wc * 32 + 4 * fq;
#pragma unroll
        for (int ai = 0; ai < 2; ++ai)
#pragma unroll
            for (int m = 0; m < 4; ++m) { float* rowp = C + (size_t)(row0 + ai * HALF + m * 16) * ldc + col0;
#pragma unroll
                for (int bj = 0; bj < 2; ++bj)
#pragma unroll
                    for (int n = 0; n < 2; ++n) *(f32x4*)(rowp + bj * HALF + n * 16) = acc[ai][bj][m][n]; }
    }
};
struct EpiPart {
    static constexpr bool PERM = false, AFTER_DRAIN = false, LDS_TABLE = false;
    float* C;
    __device__ __forceinline__ void operator()(const f32x4 (&acc)[2][2][4][2], const Unit& u, int wr, int wc, int fr, int fq) const {
        const int row0 = u.pm * BM + wr * 64 + fr, col0 = wc * 32 + 4 * fq; float* base = C + (size_t)u.aux * 1024 * 256;
#pragma unroll
        for (int ai = 0; ai < 2; ++ai)
#pragma unroll
            for (int m = 0; m < 4; ++m) { float* rowp = base + (size_t)(row0 + ai * HALF + m * 16) * 256 + col0;
#pragma unroll
                for (int bj = 0; bj < 2; ++bj)
#pragma unroll
                    for (int n = 0; n < 2; ++n) *(f32x4*)(rowp + bj * HALF + n * 16) = acc[ai][bj][m][n]; }
    }
};
template <int ACT  > struct EpiBf16 {
    static constexpr bool PERM = true, AFTER_DRAIN = false, LDS_TABLE = false;
    bf16_t* O; int ldc;
    __device__ __forceinline__ void operator()(const f32x4 (&acc)[2][2][4][2], const Unit& u, int wr, int wc, int fr, int fq) const {
        const int row0 = u.pm * BM + wr * 64 + fr, col0 = u.pn * BM + wc * 32 + 8 * fq;
#pragma unroll
        for (int ai = 0; ai < 2; ++ai)
#pragma unroll
            for (int m = 0; m < 4; ++m) { bf16_t* rowp = O + (size_t)(row0 + ai * HALF + m * 16) * ldc + col0;
#pragma unroll
                for (int bj = 0; bj < 2; ++bj) { f32x4 v0 = acc[ai][bj][m][0], v1 = acc[ai][bj][m][1];
                    if (ACT == 1) {
#pragma unroll
                        for (int j = 0; j < 4; ++j) { const float a = fmaxf(v0[j], 0.f), b = fmaxf(v1[j], 0.f); v0[j] = a * a; v1[j] = b * b; } }
                    u32x4 w; w.x = cvtpk(v0[0], v0[1]); w.y = cvtpk(v0[2], v0[3]); w.z = cvtpk(v1[0], v1[1]); w.w = cvtpk(v1[2], v1[3]);
                    *(u32x4*)(rowp + bj * HALF) = w; } }
    }
};
struct EpiProj {
    static constexpr bool PERM = true, AFTER_DRAIN = false, LDS_TABLE = true;
    bf16_t* P; bf16_t* KC; bf16_t* VC; float* GF; const _Float16* CS; const float* bfg;
    template <int bj>
    __device__ __forceinline__ void half(const f32x4 (&acc)[2][2][4][2], const Unit& u, int wr, int wc, int fr, int fq) const {
        const int row0 = u.pm * BM + wr * 64 + fr;
        const int hb = 2 * u.pn + bj;
        if (hb >= 46) {
            if (hb == 46 && wc == 0) {
#pragma unroll
                for (int ai = 0; ai < 2; ++ai)
#pragma unroll
                    for (int m = 0; m < 4; ++m) { const int row = row0 + ai * HALF + m * 16;
#pragma unroll
                        for (int n = 0; n < 2; ++n) { f32x4 v = acc[ai][bj][m][n]; f32x4 o;
#pragma unroll
                            for (int j = 0; j < 4; ++j) { const int c = 8 * fq + 4 * n + j; float x = v[j], r;
                                if (c < 12) r = __builtin_amdgcn_rcpf(1.f + __expf(-x));
                                else if (c < 20) { x += bfg[c - 12]; r = fminf(x, 0.f) - __logf(1.f + __expf(-fabsf(x))); }
                                else r = 0.f;
                                o[j] = r; }
                            *(f32x4*)(GF + (size_t)row * 32 + 8 * fq + 4 * n) = o; } }
            }
            return;
        }
    }
    static __device__ __forceinline__ bool is_rope(int hb) { return hb < 8 || (hb >= 12 && hb < 16) || hb == 16 || hb == 18 || hb == 20; }
    static constexpr int L_TAB = 139264;
    __device__ __forceinline__ bool needs_table(const Unit& u) const { return u.pn != 23 && (is_rope(2 * u.pn) || is_rope(2 * u.pn + 1)); }
    __device__ __forceinline__ void stage_table(const Unit& u, PG8_LAS unsigned char* lds, int wid, int lane_) const {
        (void)lane_; int lane = threadIdx.x; asm volatile("" : "+v"(lane)); lane &= 63;
#pragma unroll
        for (int i = 0; i < 2; ++i) { const int s = (wid * 2 + i) * 64 + lane;
            __builtin_amdgcn_global_load_lds((const unsigned*)(CS + (size_t)(u.pm * BM + (s >> 2)) * 32 + (s & 3) * 8), (PG8_LAS unsigned*)(lds + L_TAB + (wid * 2 + i) * 1024), 16, 0, 0); }
    }
    __device__ __forceinline__ void operator()(const f32x4 (&acc)[2][2][4][2], const Unit& u, int wr, int wc, int fr, int fq, PG8_LAS unsigned char* lds) const {
        if (u.pn == 23) { half<0>(acc, u, wr, wc, fr, fq); half<1>(acc, u, wr, wc, fr, fq); return; }
        typedef _Float16 h16x8 __attribute__((ext_vector_type(8)));
        const int rl0 = wr * 64 + fr, hb0 = 2 * u.pn, col0 = wc * 32 + 8 * fq;
        const bool rp0 = (wc == 0) && is_rope(hb0), rp1 = (wc == 0) && is_rope(hb0 + 1);
        const float sg = (fq < 2) ? -1.f : 1.f;
#pragma unroll
        for (int bj = 0; bj < 2; ++bj) {
            const bool rope = bj ? rp1 : rp0; const int hb = hb0 + bj;
            bf16_t* base; int ld;
            if (hb == 16) { base = KC; ld = 128; } else if (hb == 17) { base = VC; ld = 128; } else { base = P + hb * 128; ld = PW; }
#pragma unroll
            for (int ai = 0; ai < 2; ++ai)
#pragma unroll
                for (int m = 0; m < 4; ++m) { const int rl = rl0 + ai * HALF + m * 16, row = u.pm * BM + rl;
                    f32x4 v0 = acc[ai][bj][m][0], v1 = acc[ai][bj][m][1];
                    if (rope) {
                        f32x4 o0, o1;
#pragma unroll
                        for (int j = 0; j < 4; ++j) {
                            const auto s0_ = __builtin_amdgcn_permlane32_swap(__float_as_uint(v0[j]), __float_as_uint(v0[j]), false, false), s1_ = __builtin_amdgcn_permlane32_swap(__float_as_uint(v1[j]), __float_as_uint(v1[j]), false, false);
                            o0[j] = __uint_as_float(fq < 2 ? s0_[1] : s0_[0]); o1[j] = __uint_as_float(fq < 2 ? s1_[1] : s1_[0]); }
                        const h16x8 cc = *(const PG8_LAS h16x8*)(lds + L_TAB + rl * 64 + (fq & 1) * 16), ss = *(const PG8_LAS h16x8*)(lds + L_TAB + rl * 64 + 32 + (fq & 1) * 16);
                        const f32x4 c0 = {(float)cc[0], (float)cc[1], (float)cc[2], (float)cc[3]}, c1 = {(float)cc[4], (float)cc[5], (float)cc[6], (float)cc[7]};
                        const f32x4 s0 = {(float)ss[0], (float)ss[1], (float)ss[2], (float)ss[3]}, s1 = {(float)ss[4], (float)ss[5], (float)ss[6], (float)ss[7]};
                        v0 = v0 * c0 + sg * (o0 * s0); v1 = v1 * c1 + sg * (o1 * s1);
                    }
                    u32x4 w; w.x = cvtpk(v0[0], v0[1]); w.y = cvtpk(v0[2], v0[3]); w.z = cvtpk(v1[0], v1[1]); w.w = cvtpk(v1[2], v1[3]);
                    *(u32x4*)(base + (size_t)row * ld + col0) = w; }
        }
    }
};

template <class Epi, class Sched, bool ALIGN_EPI = false, bool SP2 = false>
__device__ __forceinline__ void gemm_phase(PG8_LAS unsigned char* lds, const Gemm g, const Sched& S, const Epi& E) {
    int tid_ = threadIdx.x; asm volatile("" : "+v"(tid_));
    const int tid = tid_, wid = __builtin_amdgcn_readfirstlane(tid >> 6), lane = tid & 63, wr = wid >> 2, wc = wid & 3, fr = lane & 15, fq = lane >> 4;
    const int K = g.K, nt = K / BK, lda = g.lda, ldb = g.ldb;
    unsigned voffA[2], voffB[2];
#pragma unroll
    for (int i = 0; i < 2; ++i) { int R, C; stage_rc(tid * 16 + i * 8192, R, C); const int Rb = Epi::PERM ? ((R & ~31) + perm32(R & 31)) : R;
        voffA[i] = (unsigned)(R * lda + C) * 2u; voffB[i] = (unsigned)(Rb * ldb + C) * 2u; }
    const size_t kstep = (size_t)(BK * 2);
    const size_t hstepA = (size_t)HALF * lda * 2, hstepB = (size_t)HALF * ldb * 2;
        const unsigned ldsw = (unsigned)wid * 1024u;
    const int aoff = lds_byte(wr * 64 + fr, fq * 8), boff = lds_byte(wc * 32 + fr, fq * 8);
#define PG8_SA(b, h) (((b) * 2 + (h)) * HTB)
#define PG8_SB(b, h) ((4 + (b) * 2 + (h)) * HTB)
#define PG8_STAGE(bufoff, gbase, voff) do { _Pragma("unroll") for (int _i = 0; _i < 2; ++_i) \
        __builtin_amdgcn_global_load_lds((const unsigned*)((const char*)(gbase) + (voff)[_i]), (PG8_LAS unsigned*)(lds + (bufoff) + ldsw + _i * 8192), 16, 0, 0); } while (0)
#define PG8_LDA(dst, b, h) do { _Pragma("unroll") for (int m = 0; m < 4; ++m) _Pragma("unroll") for (int k = 0; k < 2; ++k) dst[m][k] = *(const PG8_LAS bf16x8*)(lds + PG8_SA(b, h) + aoff + m * 2048 + k * 1024); } while (0)
#define PG8_LDB(dst, b, h) do { _Pragma("unroll") for (int n = 0; n < 2; ++n) _Pragma("unroll") for (int k = 0; k < 2; ++k) dst[n][k] = *(const PG8_LAS bf16x8*)(lds + PG8_SB(b, h) + boff + n * 2048 + k * 1024); } while (0)
#define PG8_MMA(ai, bj, At, Bt) do { __builtin_amdgcn_s_setprio(1); _Pragma("unroll") for (int m = 0; m < 4; ++m) _Pragma("unroll") for (int n = 0; n < 2; ++n) _Pragma("unroll") for (int k = 0; k < 2; ++k) \
        acc[ai][bj][m][n] = __builtin_amdgcn_mfma_f32_16x16x32_bf16(Bt[n][k], At[m][k], acc[ai][bj][m][n], 0, 0, 0); __builtin_amdgcn_s_setprio(0); } while (0)
#define PG8_WAIT_V(n) asm volatile("s_waitcnt vmcnt(" #n ")" ::: "memory")
#define PG8_WAIT_L(n) asm volatile("s_waitcnt lgkmcnt(" #n ")" ::: "memory")
#define PG8_BAR __builtin_amdgcn_s_barrier()
#define PG8_SCHED __builtin_amdgcn_sched_barrier(0)
    Unit cur, nxt; int ui = 0;
    if (!S.next(0, cur)) return;
    f32x4 acc[2][2][4][2];
#pragma unroll
    for (int a = 0; a < 2; ++a)
#pragma unroll
        for (int b = 0; b < 2; ++b)
#pragma unroll
            for (int m = 0; m < 4; ++m)
#pragma unroll
                for (int n = 0; n < 2; ++n) acc[a][b][m][n] = (f32x4){0.f, 0.f, 0.f, 0.f};
    bf16x8 At[4][2], B0[2][2], B1[2][2];
    const char* cA = (const char*)g.A + S.a_off(cur, g); const char* cB = (const char*)g.Bt + S.b_off(cur, g);
    S.a_ready(cur);
    if constexpr (Epi::LDS_TABLE) { if (E.needs_table(cur)) E.stage_table(cur, lds, wid, lane); }
    if constexpr (SP2) {
        PG8_STAGE(PG8_SB(0, 0), cB, voffB); PG8_STAGE(PG8_SB(0, 1), cB + hstepB, voffB); PG8_STAGE(PG8_SA(0, 0), cA, voffA); PG8_STAGE(PG8_SA(0, 1), cA + hstepA, voffA);
        if (wr == 1) PG8_BAR;
        PG8_WAIT_V(2); PG8_BAR;
        PG8_STAGE(PG8_SB(1, 0), cB + kstep, voffB); PG8_STAGE(PG8_SA(1, 0), cA + kstep, voffA); PG8_STAGE(PG8_SB(1, 1), cB + hstepB + kstep, voffB);
        PG8_WAIT_V(6); PG8_BAR;
    } else {
        PG8_STAGE(PG8_SB(0, 0), cB, voffB); PG8_STAGE(PG8_SA(0, 0), cA, voffA); PG8_STAGE(PG8_SB(0, 1), cB + hstepB, voffB); PG8_STAGE(PG8_SA(0, 1), cA + hstepA, voffA);
        if (wr == 1) PG8_BAR;
        PG8_WAIT_V(4); PG8_BAR;
        PG8_STAGE(PG8_SB(1, 0), cB + kstep, voffB); PG8_STAGE(PG8_SA(1, 0), cA + kstep, voffA); PG8_STAGE(PG8_SB(1, 1), cB + hstepB + kstep, voffB);
        PG8_WAIT_V(6); PG8_BAR;
    }
    for (;;) {
        const bool has_next = S.next(ui + 1, nxt);
        const char* nA = has_next ? (const char*)g.A + S.a_off(nxt, g) : cA; const char* nB = has_next ? (const char*)g.Bt + S.b_off(nxt, g) : cB;
        for (int t = 0; t < nt; t += 2) {
            const bool last = (t == nt - 2);
            const char* a1 = cA + (size_t)(t + 1) * kstep;
            const char* a2 = last ? nA : cA + (size_t)(t + 2) * kstep; const char* b2 = last ? nB : cB + (size_t)(t + 2) * kstep;
            const char* a3 = a2 + kstep; const char* b3 = b2 + kstep;
            if (last && has_next) S.a_ready(nxt);
            if constexpr (SP2) {
            PG8_LDB(B0, 0, 0); PG8_LDB(B1, 0, 1); PG8_SCHED; PG8_LDA(At, 0, 0); PG8_STAGE(PG8_SA(1, 1), a1 + hstepA, voffA);
            PG8_WAIT_V(8); PG8_WAIT_L(0); PG8_BAR; PG8_MMA(0, 0, At, B0); PG8_MMA(0, 1, At, B1); PG8_BAR; PG8_SCHED;
            PG8_LDA(At, 0, 1); PG8_STAGE(PG8_SB(0, 0), b2, voffB); PG8_STAGE(PG8_SB(0, 1), b2 + hstepB, voffB); PG8_STAGE(PG8_SA(0, 0), a2, voffA);
            PG8_WAIT_V(8); PG8_WAIT_L(0); PG8_BAR; PG8_MMA(1, 0, At, B0); PG8_MMA(1, 1, At, B1); PG8_BAR; PG8_SCHED;
            PG8_LDB(B0, 1, 0); PG8_LDB(B1, 1, 1); PG8_SCHED; PG8_LDA(At, 1, 0); PG8_STAGE(PG8_SA(0, 1), a2 + hstepA, voffA);
            PG8_WAIT_V(8); PG8_WAIT_L(0); PG8_BAR; PG8_MMA(0, 0, At, B0); PG8_MMA(0, 1, At, B1); PG8_BAR; PG8_SCHED;
            PG8_LDA(At, 1, 1); PG8_STAGE(PG8_SB(1, 0), b3, voffB); PG8_STAGE(PG8_SB(1, 1), b3 + hstepB, voffB); PG8_STAGE(PG8_SA(1, 0), a3, voffA);
            PG8_WAIT_V(8); PG8_WAIT_L(0); PG8_BAR; PG8_MMA(1, 0, At, B0); PG8_MMA(1, 1, At, B1); PG8_BAR; PG8_SCHED;
            } else {
            PG8_LDB(B0, 0, 0); PG8_SCHED; PG8_LDA(At, 0, 0); PG8_STAGE(PG8_SA(1, 1), a1 + hstepA, voffA);
            PG8_WAIT_L(8); PG8_BAR; PG8_WAIT_L(0); PG8_MMA(0, 0, At, B0); PG8_BAR; PG8_SCHED;
            PG8_LDB(B1, 0, 1); PG8_STAGE(PG8_SB(0, 0), b2, voffB);
            PG8_BAR; PG8_WAIT_L(0); PG8_MMA(0, 1, At, B1); PG8_BAR;
            PG8_LDA(At, 0, 1); PG8_STAGE(PG8_SA(0, 0), a2, voffA);
            PG8_BAR; PG8_WAIT_L(0); PG8_MMA(1, 0, At, B0); PG8_BAR; PG8_SCHED;
            PG8_STAGE(PG8_SB(0, 1), b2 + hstepB, voffB);
            PG8_WAIT_V(6); PG8_BAR; PG8_MMA(1, 1, At, B1); PG8_BAR;
            PG8_LDB(B0, 1, 0); PG8_SCHED; PG8_LDA(At, 1, 0); PG8_STAGE(PG8_SA(0, 1), a2 + hstepA, voffA);
            PG8_WAIT_L(8); PG8_BAR; PG8_WAIT_L(0); PG8_MMA(0, 0, At, B0); PG8_BAR; PG8_SCHED;
            PG8_LDB(B1, 1, 1); PG8_STAGE(PG8_SB(1, 0), b3, voffB);
            PG8_BAR; PG8_WAIT_L(0); PG8_MMA(0, 1, At, B1); PG8_BAR;
            PG8_LDA(At, 1, 1); PG8_STAGE(PG8_SA(1, 0), a3, voffA);
            PG8_BAR; PG8_WAIT_L(0); PG8_MMA(1, 0, At, B0); PG8_BAR; PG8_SCHED;
            PG8_STAGE(PG8_SB(1, 1), b3 + hstepB, voffB);
            PG8_WAIT_V(6); PG8_BAR; PG8_MMA(1, 1, At, B1); PG8_BAR;
            }
        }
        if constexpr (ALIGN_EPI) { if (wr == 0) PG8_BAR; }
        if constexpr (Epi::LDS_TABLE) { E(acc, cur, wr, wc, fr, fq, lds); S.done(cur); }
        else if constexpr (!Epi::AFTER_DRAIN) { E(acc, cur, wr, wc, fr, fq); S.done(cur); }
        if (!has_next) break;
#pragma unroll
        for (int a = 0; a < 2; ++a)
#pragma unroll
            for (int b = 0; b < 2; ++b)
#pragma unroll
                for (int m = 0; m < 4; ++m)
#pragma unroll
                    for (int n = 0; n < 2; ++n) acc[a][b][m][n] = (f32x4){0.f, 0.f, 0.f, 0.f};
        if constexpr (Epi::LDS_TABLE) { if (E.needs_table(nxt)) { PG8_BAR; E.stage_table(nxt, lds, wid, lane); } }
        cur = nxt; cA = nA; cB = nB; ++ui;
        if constexpr (ALIGN_EPI) { if (wr == 1) PG8_BAR; }
    }
    PG8_WAIT_V(0);
    if constexpr (!ALIGN_EPI) { if (wr == 0) PG8_BAR; }
    PG8_BAR;
    if constexpr (Epi::AFTER_DRAIN) { E.fused(acc, cur, wr, wc, fr, fq, lds, wid, lane); S.done(cur); }
#undef PG8_SA
#undef PG8_SB
#undef PG8_STAGE
#undef PG8_LDA
#undef PG8_LDB
#undef PG8_MMA
#undef PG8_WAIT_V
#undef PG8_WAIT_L
#undef PG8_BAR
#undef PG8_SCHED
}

}
#define XB_TMO      128
#define XB_XCNT(j)  (256  + 64 * (j))
#define XB_XSUB(j)  (1280 + 64 * (j))
#define XB_XGEN(j)  (2304 + 64 * (j))
#define XB_TOP      3328
#define XB_TOPGEN   3392
#define XCD_BAR_WORDS 3456
#define XB_SPIN_CAP (1u << 18)

__device__ __forceinline__ unsigned xb_ld(unsigned* p)              { return __hip_atomic_load(p, __ATOMIC_RELAXED, __HIP_MEMORY_SCOPE_AGENT); }
__device__ __forceinline__ unsigned xb_add(unsigned* p, unsigned v) { return __hip_atomic_fetch_add(p, v, __ATOMIC_RELAXED, __HIP_MEMORY_SCOPE_AGENT); }
__device__ __forceinline__ unsigned xb_xcc_id() { return (unsigned)__builtin_amdgcn_s_getreg((3 << 11) | 20) & 0xFu; }
#define XB_SPIN(cond, bar) do { unsigned _sp = 0; while (cond) { __builtin_amdgcn_s_sleep(1); \
    if ((++_sp & 255u) == 0u) { if (xb_ld(&(bar)[XB_TMO])) break; if (_sp > XB_SPIN_CAP) { atomicAdd(&(bar)[XB_TMO], 1u); break; } } } } while (0)

struct XcdBarrier {
    unsigned* bar; unsigned x;
    volatile LAS unsigned* st;
};

__device__ __forceinline__ XcdBarrier xcd_barrier_post(unsigned* bar, volatile LAS unsigned* st) {
    XcdBarrier b; b.bar = bar; b.x = xb_xcc_id(); b.st = st;
    if (threadIdx.x == 0) (void)xb_add(&bar[XB_XCNT(b.x)], 1u);
    return b;
}
__device__ __forceinline__ void xcd_barrier_complete(unsigned* bar, unsigned x, unsigned& nloc, unsigned& nx) {
    const unsigned G = gridDim.x * gridDim.y * gridDim.z;
    unsigned sum, cnt, mine, sp = 0u;
    for (;;) {
        sum = 0u; cnt = 0u; mine = 0u;
#pragma unroll
        for (unsigned j = 0; j < 16; ++j) { const unsigned c = xb_ld(&bar[XB_XCNT(j)]); sum += c; cnt += (c > 0u) ? 1u : 0u; mine = (j == x) ? c : mine; }
        if (sum == G) break;
        __builtin_amdgcn_s_sleep(1);
        if ((++sp & 255u) == 0u) { if (xb_ld(&bar[XB_TMO])) break; if (sp > XB_SPIN_CAP) { atomicAdd(&bar[XB_TMO], 1u); break; } }
    }
    nloc = mine > 0u ? mine : 1u; nx = cnt > 0u ? cnt : 1u;
}

__device__ __noinline__ void xcd_barrier(const XcdBarrier b) {
    asm volatile("s_waitcnt vmcnt(0)" ::: "memory");
    __syncthreads();
    if (threadIdx.x == 0) {
        unsigned* bar = b.bar;
        __builtin_amdgcn_s_waitcnt(0);
        unsigned nloc = b.st[0], nx = b.st[1];
        if (nloc == 0u) { xcd_barrier_complete(bar, b.x, nloc, nx); b.st[0] = nloc; b.st[1] = nx; }
        const unsigned old = xb_add(&bar[XB_XSUB(b.x)], 1u);
        const unsigned gen = old / nloc;
        if (old + 1u == (gen + 1u) * nloc) {
            __builtin_amdgcn_fence(__ATOMIC_RELEASE, "agent");
            asm volatile("s_waitcnt vmcnt(0)" ::: "memory");
            const unsigned og = xb_add(&bar[XB_TOP], 1u);
            const unsigned tg = og / nx;
            if (og + 1u == (tg + 1u) * nx) xb_add(&bar[XB_TOPGEN], 1u);
            else XB_SPIN(xb_ld(&bar[XB_TOPGEN]) == tg, bar);
            __builtin_amdgcn_fence(__ATOMIC_ACQUIRE, "agent");
            xb_add(&bar[XB_XGEN(b.x)], 1u);
            asm volatile("s_waitcnt vmcnt(0)" ::: "memory");
        } else {
            XB_SPIN(xb_ld(&bar[XB_XGEN(b.x)]) == gen, bar);
            __builtin_amdgcn_fence(__ATOMIC_ACQUIRE, "agent");
            asm volatile("s_waitcnt vmcnt(0)" ::: "memory");
        }
    }
    __syncthreads();
}
namespace att {
enum { M_FOX = 0, M_MOBA = 1, M_SEL = 2, M_WIN = 3, M_CMP = 4 };
constexpr int NW = 8, QBLK = 32, KVBLK = 64, D = 128;
constexpr int SHM_V = KVBLK * D * 2, SHM_K = KVBLK * D * 2;
constexpr int L_WS = 2 * SHM_V + 2 * SHM_K;
constexpr int L_AUX = L_WS + NW * 64 * 4;
constexpr int L_BITS = L_AUX + 32768;
constexpr int L_END = L_BITS + 1024;
constexpr float THR = 8.f;
constexpr float SCALE = SM_SCALE;

#define KSWZ(row, colB) ((row) * 256 + ((colB) ^ (((row) & 7) << 4)))
#define SBAR() __builtin_amdgcn_sched_barrier(0)
__device__ __forceinline__ int v_st(int k, int c) { const int kk = (k & ~0xC) | ((k & 4) << 1) | ((k & 8) >> 1); return ((kk >> 3) * 4 + (c >> 5)) * 512 + ((kk & 7) * 32 + (c & 31)) * 2; }
__device__ __forceinline__ int v_rd_base(int lane) { return ((lane & 3) << 3) | (((lane >> 2) & 3) << 6) | (((lane >> 4) & 1) << 5) | (((lane >> 5) & 1) << 8); }
constexpr int v_rd_off(int d0, int ks, int half) { return d0 * 512 + ks * 4096 + half * 2048; }
__device__ __forceinline__ int crow(int r, int hi) { return (r & 3) + 8 * (r >> 2) + 4 * hi; }

__device__ __forceinline__ void mask_tile(f32x16& p0, f32x16& p1, int dq, unsigned W) {
    const float NEG = -__builtin_inff();
#pragma unroll
    for (int r = 0; r < 16; ++r) {
        const int c = (r & 3) + 8 * (r >> 2);
        if ((unsigned)(dq - c) >= W) p0[r] = NEG;
        if ((unsigned)(dq - c - 32) >= W) p1[r] = NEG;
    }
}
template <bool FOXCUT = false>
__device__ __forceinline__ bool partialSM(f32x16& p0, f32x16& p1, float& m_reg, float& mn, float& alpha) {
    float pmax = p0[0]; for (int r = 1; r < 16; ++r) pmax = fmaxf(pmax, p0[r]); for (int r = 0; r < 16; ++r) pmax = fmaxf(pmax, p1[r]);
    { auto rr = __builtin_amdgcn_permlane32_swap(__float_as_uint(pmax), __float_as_uint(pmax), false, false);
      pmax = fmaxf(__uint_as_float(rr[0]), __uint_as_float(rr[1])); }
    constexpr float C2 = 1.4426950408889634f * SCALE;
    if (FOXCUT && __all(pmax < m_reg - 32.f / SCALE)) { mn = m_reg; alpha = 1.f; return false; }
    if (__builtin_expect(__all((pmax - m_reg) * SCALE <= THR), 1)) { mn = m_reg; alpha = 1.f; }
    else { mn = fmaxf(m_reg, pmax); alpha = __builtin_amdgcn_exp2f((m_reg - mn) * C2); m_reg = mn; }
    const float mnL = -mn * C2;
    for (int r = 0; r < 16; ++r) p0[r] = fmaf(p0[r], C2, mnL); for (int r = 0; r < 16; ++r) p1[r] = fmaf(p1[r], C2, mnL);
    for (int r = 0; r < 16; ++r) p0[r] = __builtin_amdgcn_exp2f(p0[r]);
    return true;
}
__device__ __forceinline__ void finishSM(f32x16& p0, f32x16& p1, float alpha, float& l_reg, bf16x8& pa0, bf16x8& pa1, bf16x8& pa2, bf16x8& pa3) {
    for (int r = 0; r < 16; ++r) p1[r] = __builtin_amdgcn_exp2f(p1[r]);
    float ps = 0; for (int r = 0; r < 16; ++r) ps += p0[r]; for (int r = 0; r < 16; ++r) ps += p1[r];
    { auto rr = __builtin_amdgcn_permlane32_swap(__float_as_uint(ps), __float_as_uint(ps), false, false);
      ps = __uint_as_float(rr[0]) + __uint_as_float(rr[1]); }
    l_reg = l_reg * alpha + ps;
#define PK4(P, B_, OUT) do { unsigned a0 = cvtpk(P[B_+0], P[B_+1]), a1 = cvtpk(P[B_+2], P[B_+3]);                          \
        unsigned b0 = cvtpk(P[B_+4], P[B_+5]), b1 = cvtpk(P[B_+6], P[B_+7]);                                             \
        auto r0 = __builtin_amdgcn_permlane32_swap(a0, b0, false, false); auto r1 = __builtin_amdgcn_permlane32_swap(a1, b1, false, false); \
        u32x4 w = {r0[0], r1[0], r0[1], r1[1]}; OUT = *reinterpret_cast<bf16x8*>(&w); } while (0)
    PK4(p0, 0, pa0); PK4(p0, 8, pa1); PK4(p1, 0, pa2); PK4(p1, 8, pa3);
#undef PK4
}
struct Init { float cq; const float* ck; unsigned bits; const unsigned* tokbits; };
template <int KB, int MODE>
__device__ __forceinline__ void qkt(f32x16& p0, f32x16& p1, const char* K_lds, int r32, int hi, const bf16x8* qr, bool act, int kb, const Init& I) {
    const float NEG = -__builtin_inff();
    if ((MODE == M_SEL || MODE == M_FOX) && !act) return;
    if constexpr (MODE == M_FOX) {
        const float* c = I.ck + kb + 4 * hi;
#pragma unroll
        for (int g = 0; g < 4; ++g) { const f32x4 a = *(const f32x4*)(c + 8 * g), b = *(const f32x4*)(c + 32 + 8 * g);
#pragma unroll
            for (int i = 0; i < 4; ++i) { p0[4 * g + i] = a[i]; p1[4 * g + i] = b[i]; } }
    } else if constexpr (MODE == M_MOBA) {
        const float v = ((I.bits >> (kb >> 8)) & 1u) ? 0.f : NEG;
#pragma unroll
        for (int r = 0; r < 16; ++r) { p0[r] = v; p1[r] = v; }
    } else if constexpr (MODE == M_SEL) {
        const int j = kb >> 6; const unsigned w = I.tokbits[j >> 5]; const float v = ((w >> (j & 31)) & 1u) ? 0.f : NEG;
#pragma unroll
        for (int r = 0; r < 16; ++r) { p0[r] = v; p1[r] = v; }
    } else { p0 = f32x16{}; p1 = f32x16{}; }
    int kad[4];
#pragma unroll
    for (int dd = 0; dd < 4; ++dd) kad[dd] = (int)(uintptr_t)K_lds + KSWZ(r32, (dd * 16 + hi * 8) * 2);
    bf16x8 f0, f1, f2, f3;
#define KRD(dst, d0, w) asm volatile("ds_read_b128 %0, %1 offset:%2" : "=v"(dst) : "v"(kad[(d0) & 3]), "i"(KB * SHM_K + ((d0) >> 2) * 128 + (w) * 8192) : "memory")
#define KWT(n, x) asm volatile("s_waitcnt lgkmcnt(" #n ")" : "+v"(x) :: "memory")
#define KMM(P, f, d0) P = __builtin_amdgcn_mfma_f32_32x32x16_bf16(f, qr[d0], P, 0, 0, 0)
    KRD(f0, 0, 0); KRD(f1, 0, 1); KRD(f2, 1, 0); KRD(f3, 1, 1);
    KWT(3, f0); KMM(p0, f0, 0); KRD(f0, 2, 0);  KWT(3, f1); KMM(p1, f1, 0); KRD(f1, 2, 1);
    KWT(3, f2); KMM(p0, f2, 1); KRD(f2, 3, 0);  KWT(3, f3); KMM(p1, f3, 1); KRD(f3, 3, 1);
    KWT(3, f0); KMM(p0, f0, 2); KRD(f0, 4, 0);  KWT(3, f1); KMM(p1, f1, 2); KRD(f1, 4, 1);
    KWT(3, f2); KMM(p0, f2, 3); KRD(f2, 5, 0);  KWT(3, f3); KMM(p1, f3, 3); KRD(f3, 5, 1);
    KWT(3, f0); KMM(p0, f0, 4); KRD(f0, 6, 0);  KWT(3, f1); KMM(p1, f1, 4); KRD(f1, 6, 1);
    KWT(3, f2); KMM(p0, f2, 5); KRD(f2, 7, 0);  KWT(3, f3); KMM(p1, f3, 5); KRD(f3, 7, 1);
    KWT(3, f0); KMM(p0, f0, 6);                 KWT(2, f1); KMM(p1, f1, 6);
    KWT(1, f2); KMM(p0, f2, 7);                 KWT(0, f3); KMM(p1, f3, 7);
#undef KRD
#undef KWT
#undef KMM
}
template <int VB, bool SK>
__device__ __forceinline__ void pv_tile(f32x16* o, int vb0, bf16x8 pa0, bf16x8 pa1, bf16x8 pa2, bf16x8 pa3, bool act) {
    if (SK && !act) return;
    s16x4 l0, l1, l2, l3, h0, h1, h2, h3;
#define TRRD(dst, off) asm volatile("ds_read_b64_tr_b16 %0, %1 offset:%2" : "=&v"(dst) : "v"(vb0), "i"(off) : "memory")
#define VRD2(d0, j) do { constexpr int b_ = VB * SHM_V + v_rd_off(d0, 0, 0) + (j) * 4096; TRRD(l##j, b_); TRRD(h##j, b_ + 2048); } while (0)
#define VFR(j) (bf16x8){l##j[0], l##j[1], l##j[2], l##j[3], h##j[0], h##j[1], h##j[2], h##j[3]}
#define VWT(n) do { asm volatile("s_waitcnt lgkmcnt(" #n ")" : "+v"(l0), "+v"(l1), "+v"(l2), "+v"(l3), "+v"(h0), "+v"(h1), "+v"(h2), "+v"(h3) :: "memory"); } while (0)
    VRD2(0, 0); VRD2(0, 1); VRD2(0, 2); VRD2(0, 3);
    VWT(6); o[0] = __builtin_amdgcn_mfma_f32_32x32x16_bf16(pa0, VFR(0), o[0], 0, 0, 0); VRD2(1, 0);
    VWT(6); o[0] = __builtin_amdgcn_mfma_f32_32x32x16_bf16(pa1, VFR(1), o[0], 0, 0, 0); VRD2(1, 1);
    VWT(6); o[0] = __builtin_amdgcn_mfma_f32_32x32x16_bf16(pa2, VFR(2), o[0], 0, 0, 0); VRD2(1, 2);
    VWT(6); o[0] = __builtin_amdgcn_mfma_f32_32x32x16_bf16(pa3, VFR(3), o[0], 0, 0, 0); VRD2(1, 3);
    VWT(6); o[1] = __builtin_amdgcn_mfma_f32_32x32x16_bf16(pa0, VFR(0), o[1], 0, 0, 0); VRD2(2, 0);
    VWT(6); o[1] = __builtin_amdgcn_mfma_f32_32x32x16_bf16(pa1, VFR(1), o[1], 0, 0, 0); VRD2(2, 1);
    VWT(6); o[1] = __builtin_amdgcn_mfma_f32_32x32x16_bf16(pa2, VFR(2), o[1], 0, 0, 0); VRD2(2, 2);
    VWT(6); o[1] = __builtin_amdgcn_mfma_f32_32x32x16_bf16(pa3, VFR(3), o[1], 0, 0, 0); VRD2(2, 3);
    VWT(6); o[2] = __builtin_amdgcn_mfma_f32_32x32x16_bf16(pa0, VFR(0), o[2], 0, 0, 0); VRD2(3, 0);
    VWT(6); o[2] = __builtin_amdgcn_mfma_f32_32x32x16_bf16(pa1, VFR(1), o[2], 0, 0, 0); VRD2(3, 1);
    VWT(6); o[2] = __builtin_amdgcn_mfma_f32_32x32x16_bf16(pa2, VFR(2), o[2], 0, 0, 0); VRD2(3, 2);
    VWT(6); o[2] = __builtin_amdgcn_mfma_f32_32x32x16_bf16(pa3, VFR(3), o[2], 0, 0, 0); VRD2(3, 3);
    VWT(6); o[3] = __builtin_amdgcn_mfma_f32_32x32x16_bf16(pa0, VFR(0), o[3], 0, 0, 0);
    VWT(4); o[3] = __builtin_amdgcn_mfma_f32_32x32x16_bf16(pa1, VFR(1), o[3], 0, 0, 0);
    VWT(2); o[3] = __builtin_amdgcn_mfma_f32_32x32x16_bf16(pa2, VFR(2), o[3], 0, 0, 0);
    VWT(0); o[3] = __builtin_amdgcn_mfma_f32_32x32x16_bf16(pa3, VFR(3), o[3], 0, 0, 0);
#undef TRRD
#undef VRD2
#undef VFR
#undef VWT
}

constexpr int L_STG = 139264;
__device__ __forceinline__ void stg_write(char* stg, const f32x16* o, const float (&rli)[16], int q, int r32, int hi) {
#pragma unroll
    for (int rr = 0; rr < 4; ++rr)
#pragma unroll
        for (int d0 = 0; d0 < 4; ++d0) { const int col = d0 * 32 + r32, rc = rr + 4 * hi;
            const float v = o[d0][4 * q + rr] * rli[4 * q + rr];
            *(unsigned short*)(stg + rc * 256 + ((((col >> 3) ^ (hi << 2)) << 4) | ((col & 7) << 1))) = (unsigned short)cvtpk(v, v); }
}
__device__ __forceinline__ u32x4 stg_read(const char* stg, int i, int lane, int& rc, int& ch) {
    const int idx = i * 64 + lane; rc = idx >> 4; ch = idx & 15;
    return *(const u32x4*)(stg + rc * 256 + ((ch ^ ((rc >> 2) << 2)) << 4));
}

struct Ref { const bf16_t* Q; const bf16_t* K; const bf16_t* V; int kvp, P0, skv, jlo; };
struct Out { bf16_t* O; float* scr; const float* gf; int br; };
template <int MODE, bool LOADQ>
__device__ __forceinline__ void attn_pass(const Ref& R, char* lds, bf16x8 (&qr)[8], const Out& E, float& m_out, float& l_out, unsigned long long wor_lo, unsigned long long wor_hi) {
    constexpr bool NSA = (MODE == M_SEL || MODE == M_WIN || MODE == M_CMP);
    constexpr bool SK = (MODE == M_SEL || MODE == M_FOX);
    int tid_ = threadIdx.x; asm volatile("" : "+v"(tid_));
    const int tid = tid_, wid = __builtin_amdgcn_readfirstlane(tid >> 6), lane = tid & 63, r32 = lane & 31, hi = lane >> 5;
    const int pos = NSA ? R.P0 + 8 * wid + (r32 >> 2) : R.P0 + 32 * wid + r32;
    const int qlo_p = NSA ? R.P0 + 8 * wid : R.P0 + 32 * wid, qhi_p = NSA ? qlo_p + 7 : qlo_p + 31, P1 = R.P0 + (NSA ? 63 : 255);
    const int mp = (MODE == M_CMP) ? ((pos - 31) >> 4) : pos;
    const int qlo = (MODE == M_CMP) ? ((qlo_p - 31) >> 4) : qlo_p, qhi = (MODE == M_CMP) ? ((qhi_p - 31) >> 4) : qhi_p, mP1 = (MODE == M_CMP) ? ((P1 - 31) >> 4) : P1;
    constexpr int W = (MODE == M_WIN) ? 512 : (1 << 30);
    int j_lo = R.jlo; if (MODE == M_WIN) { const int lowk = R.P0 - 511; j_lo = lowk > 0 ? lowk / KVBLK : 0; }
    int j_hi = mP1 / KVBLK + 1; if (j_hi > R.skv / KVBLK) j_hi = R.skv / KVBLK;
    const int NT = j_hi - j_lo;
    const int wjlo = (MODE == M_FOX) ? (int)wor_lo : 0;
    const int qm = mp - 4 * hi;
    char* V_lds = lds; char* K_lds = lds + 2 * SHM_V;
    float* ws = (float*)(lds + L_WS) + wid * 64; float* li_l = ws, * al_l = ws + 32;
    float m_reg = -1e30f, l_reg = 0; f32x16 o[4] = {};
    const int sr = tid >> 4, sc = (tid & 15) * 8, vst0 = v_st(sr, sc), vst1 = v_st(32 + sr, sc), kws = KSWZ(sr, sc * 2);
    const int vb0 = (int)(uintptr_t)V_lds + v_rd_base(lane);
    const bf16_t* Kh = R.K; const bf16_t* Vh = R.V; const int kvp = R.kvp;
    Init I; I.cq = 0.f; I.ck = (const float*)(lds + L_AUX); I.bits = 0u; I.tokbits = (const unsigned*)(lds + L_BITS);
    if constexpr (MODE == M_MOBA) I.bits = ((const unsigned*)(lds + L_BITS))[32 * wid + r32];
    if constexpr (MODE == M_SEL) I.tokbits = (const unsigned*)(lds + L_BITS) + (8 * wid + (r32 >> 2)) * 4;
    bf16x8 st_v0, st_v1, st_k0, st_k1;
#define ROWP(p, k0, rr) ((p) + (size_t)((k0) + (rr)) * kvp + sc)
#define SLOAD_H(k0) do { st_v0 = *(const bf16x8*)ROWP(Vh, k0, sr); st_v1 = *(const bf16x8*)ROWP(Vh, k0, 32 + sr);              \
                         st_k0 = *(const bf16x8*)ROWP(Kh, k0, sr); st_k1 = *(const bf16x8*)ROWP(Kh, k0, 32 + sr); } while (0)
#define SWRITE_HK(bf) do { *(bf16x8*)(K_lds + (bf) * SHM_K + kws) = st_k0; *(bf16x8*)(K_lds + (bf) * SHM_K + kws + 32 * 256) = st_k1; } while (0)
#define SWRITE_HV(bf) do { *(bf16x8*)(V_lds + (bf) * SHM_V + vst0) = st_v0; *(bf16x8*)(V_lds + (bf) * SHM_V + vst1) = st_v1; } while (0)
#define SWRITE_H(bf) do { SWRITE_HV(bf); SWRITE_HK(bf); } while (0)
#define RESC(a) do { if (__any((a) < 1.f)) { if (hi == 0) al_l[r32] = (a); asm volatile("s_waitcnt lgkmcnt(0)" ::: "memory");              \
                     for (int d_ = 0; d_ < 4; ++d_) for (int r = 0; r < 16; ++r) o[d_][r] *= al_l[crow(r, hi)]; } } while (0)
#define KBASE(t) ((MODE == M_FOX ? (j_hi - 1 - (t)) : (j_lo + (t))) * KVBLK)
#define SELBIT(t) ((((j_lo + (t)) < 64 ? (wor_lo >> (j_lo + (t))) : (wor_hi >> ((j_lo + (t)) - 64))) & 1ull) != 0ull)
#define FOXACT(t) (KBASE(t) <= qhi && (j_hi - 1 - (t)) >= wjlo)
#define ACT(t) (!SK || (MODE == M_FOX ? FOXACT(t) : SELBIT(t)))
#define PSM(P0_, P1_, mn_, al_, t, LV_) do { if (ACT(t)) LV_ = partialSM<MODE == M_FOX>(P0_, P1_, m_reg, mn_, al_); else { al_ = 1.f; LV_ = false; } } while (0)
#define FSM(P0_, P1_, al_, LV_) do { if (LV_) finishSM(P0_, P1_, al_, l_reg, pa0, pa1, pa2, pa3); } while (0)
#define MASKT(P0_, P1_, t) do { const int kb_ = KBASE(t); if (ACT(t) && (kb_ + KVBLK - 1 > qlo || kb_ <= qhi - W)) mask_tile(P0_, P1_, qm - kb_, (unsigned)W); } while (0)
    if constexpr (LOADQ) {
        const bf16_t* qrow = NSA ? R.Q + (size_t)(8 * wid + (r32 >> 2)) * PW + (r32 & 3) * 128 : R.Q + (size_t)(32 * wid + r32) * PW;
#pragma unroll
        for (int d0 = 0; d0 < 8; ++d0) qr[d0] = *(const bf16x8*)(qrow + d0 * 16 + hi * 8);
    }
    SLOAD_H(KBASE(0)); VM_WAIT(); SWRITE_HK(0);
    __syncthreads();
    f32x16 pA0, pA1, pB0, pB1; float mnA, mnB, alA, alB; bf16x8 pa0, pa1, pa2, pa3;
    SWRITE_HV(0); SBAR();
    if (NT > 1) SLOAD_H(KBASE(1));
    SBAR(); qkt<0, MODE>(pA0, pA1, K_lds, r32, hi, qr, ACT(0), KBASE(0), I);
    bool lvA = true, lvB = true;
    MASKT(pA0, pA1, 0); PSM(pA0, pA1, mnA, alA, 0, lvA);
    if (NT > 1) { VM_WAIT(); SWRITE_H(1); }
    __syncthreads();
#define HALF_STEP(PX0, PX1, mnX, alX, lvX, PY0, PY1, alY, lvY, t, KB, VB, SB) do {                                                      \
        SBAR(); if ((t) + 1 < NT) { SLOAD_H(KBASE((t) + 1)); SBAR(); }         \
        qkt<KB, MODE>(PX0, PX1, K_lds, r32, hi, qr, ACT(t), KBASE(t), I);                                                     \
        FSM(PY0, PY1, alY, lvY); SBAR();                                                                                      \
        pv_tile<VB, true>(o, vb0, pa0, pa1, pa2, pa3, lvY); MASKT(PX0, PX1, (t)); PSM(PX0, PX1, mnX, alX, (t), lvX);          \
        __syncthreads();                                                                                                      \
        if ((t) + 1 < NT) { VM_WAIT(); SWRITE_H(SB); }                                                                        \
        RESC(alX); __syncthreads(); } while (0)
    for (int t = 1; t + 1 < NT; t += 2) {
        HALF_STEP(pB0, pB1, mnB, alB, lvB, pA0, pA1, alA, lvA, t, 1, 0, 0);
        HALF_STEP(pA0, pA1, mnA, alA, lvA, pB0, pB1, alB, lvB, t + 1, 0, 1, 1);
    }
    const bool even = (NT & 1) == 0;
    if (even) { SBAR(); qkt<1, MODE>(pB0, pB1, K_lds, r32, hi, qr, ACT(NT - 1), KBASE(NT - 1), I); SBAR(); }
    FSM(pA0, pA1, alA, lvA); SBAR();
    pv_tile<0, true>(o, vb0, pa0, pa1, pa2, pa3, lvA);
    if (even) { MASKT(pB0, pB1, NT - 1); PSM(pB0, pB1, mnB, alB, NT - 1, lvB); __syncthreads(); RESC(alB);
        FSM(pB0, pB1, alB, lvB); SBAR(); pv_tile<1, true>(o, vb0, pa0, pa1, pa2, pa3, lvB); }
    SBAR();
    m_out = m_reg; l_out = l_reg;
    {
        float f = l_reg > 0.f ? 1.f / l_reg : 0.f;
        if constexpr (NSA) f *= E.gf[(size_t)(8 * wid + (r32 >> 2)) * 32 + (r32 & 3) * 3 + E.br];
        if (hi == 0) li_l[r32] = f;
        asm volatile("s_waitcnt lgkmcnt(0)" ::: "memory");
    }
    float rli[16];
#pragma unroll
    for (int r = 0; r < 16; ++r) rli[r] = li_l[crow(r, hi)];
    char* stg = lds + L_STG + wid * 2048;
    bf16_t* pbuf = (bf16_t*)E.scr;
#pragma unroll
    for (int q = 0; q < 4; ++q) {
        stg_write(stg, o, rli, q, r32, hi);
        asm volatile("" ::: "memory");
#pragma unroll
        for (int i = 0; i < 2; ++i) { int rc, ch; const u32x4 w = stg_read(stg, i, lane, rc, ch); const int orow = 8 * q + rc;
            if constexpr (!NSA) *(u32x4*)(E.O + (size_t)(wid * QBLK + orow) * DM + ch * 8) = w;
            else if constexpr (MODE == M_CMP || MODE == M_SEL) *(u32x4*)(pbuf + (size_t)((MODE == M_SEL ? 256 : 0) + wid * QBLK + orow) * 128 + ch * 8) = w;
            else {
                const u32x4 a = *(const u32x4*)(pbuf + (size_t)(wid * QBLK + orow) * 128 + ch * 8), b = *(const u32x4*)(pbuf + (size_t)(256 + wid * QBLK + orow) * 128 + ch * 8);
                u32x4 r;
#pragma unroll
                for (int j = 0; j < 4; ++j) {
                    const float lo = __builtin_bit_cast(float, w[j] << 16) + __builtin_bit_cast(float, a[j] << 16) + __builtin_bit_cast(float, b[j] << 16);
                    const float hh = __builtin_bit_cast(float, w[j] & 0xffff0000u) + __builtin_bit_cast(float, a[j] & 0xffff0000u) + __builtin_bit_cast(float, b[j] & 0xffff0000u);
                    r[j] = cvtpk(lo, hh); }
                *(u32x4*)(E.O + (size_t)(8 * wid + (orow >> 2)) * DM + (orow & 3) * 128 + ch * 8) = r; }
        }
        asm volatile("" ::: "memory");
    }
    __syncthreads();
#undef ROWP
#undef SLOAD_H
#undef SWRITE_HK
#undef SWRITE_HV
#undef SWRITE_H
#undef RESC
#undef KBASE
#undef SELBIT
#undef FOXACT
#undef ACT
#undef MASKT
#undef PSM
#undef FSM
#undef HALF_STEP
}

__device__ __forceinline__ void cmp_imp_pass(const bf16_t* Kc  , int P0, char* lds, const bf16x8 (&qr)[8], float m_reg, float l_reg) {
    int tid_ = threadIdx.x; asm volatile("" : "+v"(tid_));
    const int tid = tid_, wid = __builtin_amdgcn_readfirstlane(tid >> 6), lane = tid & 63, r32 = lane & 31, hi = lane >> 5;
    const int pos = P0 + 8 * wid + (r32 >> 2), mp = (pos - 31) >> 4, qm = mp - 4 * hi;
    const int mP1 = (P0 + 63 - 31) >> 4; int NT = mP1 / KVBLK + 1; if (NT > 8) NT = 8;
    float* imp = (float*)(lds + L_AUX);
    const int sr = tid >> 4, sc = (tid & 15) * 8, kws = KSWZ(sr, sc * 2);
    constexpr float C2 = 1.4426950408889634f * SCALE;
    const float mL = -m_reg * C2, rl = l_reg > 0.f ? 1.f / l_reg : 0.f;
    Init I; I.cq = 0.f; I.ck = nullptr; I.bits = 0u; I.tokbits = nullptr;
    const int tb = 8 * wid + (r32 >> 2);
    bf16x8 ka[8], kb[8];
#define CIP_LOAD(dst, base) do { _Pragma("unroll") for (int t = 0; t < 4; ++t) if ((base) + t < NT) {                              \
        dst[2 * t] = *(const bf16x8*)(Kc + (size_t)(((base) + t) * KVBLK + sr) * 128 + sc); dst[2 * t + 1] = *(const bf16x8*)(Kc + (size_t)(((base) + t) * KVBLK + 32 + sr) * 128 + sc); } } while (0)
#define CIP_WRITE(src, base) do { _Pragma("unroll") for (int t = 0; t < 4; ++t) if ((base) + t < NT) {                             \
        *(bf16x8*)(lds + t * SHM_K + kws) = src[2 * t]; *(bf16x8*)(lds + t * SHM_K + kws + 32 * 256) = src[2 * t + 1]; } } while (0)
#define CIP_TILE(t_) do { const int kb_ = (t_) * KVBLK; f32x16 p0, p1;                                                               \
        qkt<0, M_CMP>(p0, p1, lds + ((t_) & 3) * SHM_K, r32, hi, qr, true, kb_, I);                                                 \
        mask_tile(p0, p1, qm - kb_, 1u << 30);                                                                                      \
        _Pragma("unroll") for (int r = 0; r < 16; ++r) { p0[r] = __builtin_amdgcn_exp2f(fmaf(p0[r], C2, mL)) * rl; p1[r] = __builtin_amdgcn_exp2f(fmaf(p1[r], C2, mL)) * rl; }   \
        _Pragma("unroll") for (int half = 0; half < 2; ++half) _Pragma("unroll") for (int g = 0; g < 4; ++g) {                      \
            float s4, e3;                                                                                                           \
            if (half == 0) { s4 = (p0[4 * g] + p0[4 * g + 1]) + (p0[4 * g + 2] + p0[4 * g + 3]); e3 = p0[4 * g + 3]; }              \
            else { s4 = (p1[4 * g] + p1[4 * g + 1]) + (p1[4 * g + 2] + p1[4 * g + 3]); e3 = p1[4 * g + 3]; }                        \
            s4 += __shfl_xor(s4, 1); s4 += __shfl_xor(s4, 2); e3 += __shfl_xor(e3, 1); e3 += __shfl_xor(e3, 2);     \
            const int n = (kb_ >> 2) + 8 * half + 2 * g + hi;                                                                        \
            if ((r32 & 3) == 0) { atomicAdd(&imp[tb * 128 + n], s4); if (n + 1 < 128) atomicAdd(&imp[tb * 128 + n + 1], e3); } } } while (0)
    CIP_LOAD(ka, 0);
    __syncthreads();
    CIP_WRITE(ka, 0);
    if (NT > 4) CIP_LOAD(kb, 4);
    __syncthreads();
    for (int t = 0; t < 4 && t < NT; ++t) CIP_TILE(t);
    if (NT > 4) {
        __syncthreads();
        CIP_WRITE(kb, 4);
        __syncthreads();
        for (int t = 4; t < NT; ++t) CIP_TILE(t);
    }
    __syncthreads();
#undef CIP_LOAD
#undef CIP_WRITE
#undef CIP_TILE
}

constexpr int MB_WS = 131072 + 4096;
__device__ __forceinline__ void moba_block_load(const bf16_t* K  , const bf16_t* V, char* lds) {
    int tid_ = threadIdx.x; asm volatile("" : "+v"(tid_));
    const int tid = tid_, sr = tid >> 4, sc = (tid & 15) * 8, vst0 = v_st(sr, sc), vst1 = v_st(32 + sr, sc), kws = KSWZ(sr, sc * 2);
    bf16x8 kk[8], vv[8];
#pragma unroll
    for (int t = 0; t < 4; ++t) { kk[2 * t] = *(const bf16x8*)(K + (size_t)(64 * t + sr) * PW + sc); kk[2 * t + 1] = *(const bf16x8*)(K + (size_t)(64 * t + 32 + sr) * PW + sc);
        vv[2 * t] = *(const bf16x8*)(V + (size_t)(64 * t + sr) * PW + sc); vv[2 * t + 1] = *(const bf16x8*)(V + (size_t)(64 * t + 32 + sr) * PW + sc); }
    __syncthreads();
#pragma unroll
    for (int t = 0; t < 4; ++t) { *(bf16x8*)(lds + 65536 + t * SHM_K + kws) = kk[2 * t]; *(bf16x8*)(lds + 65536 + t * SHM_K + kws + 32 * 256) = kk[2 * t + 1];
        *(bf16x8*)(lds + t * SHM_V + vst0) = vv[2 * t]; *(bf16x8*)(lds + t * SHM_V + vst1) = vv[2 * t + 1]; }
    __syncthreads();
}
template <bool CAUSAL>
__device__ __forceinline__ void moba_block_groups(const bf16_t* Qb  , const unsigned* lst, int cnt, int jblk, bf16_t* part, float* stat, char* lds) {
    int tid_ = threadIdx.x; asm volatile("" : "+v"(tid_));
    const int tid = tid_, wid = __builtin_amdgcn_readfirstlane(tid >> 6), lane = tid & 63, r32 = lane & 31, hi = lane >> 5;
    char* K_lds = lds + 65536 - 2 * SHM_V;
    K_lds = lds + 65536;
    const int vb0 = (int)(uintptr_t)lds + v_rd_base(lane);
    float* ws = (float*)(lds + MB_WS) + wid * 96; float* li_l = ws, * al_l = ws + 32; unsigned* en_l = (unsigned*)(ws + 64);
    const int ngroups = (cnt + 31) >> 5;
    Init I; I.cq = 0.f; I.ck = nullptr; I.bits = 0u; I.tokbits = nullptr;
#define RESC(a) do { if (__any((a) < 1.f)) { if (hi == 0) al_l[r32] = (a); asm volatile("s_waitcnt lgkmcnt(0)" ::: "memory");              \
                     for (int d_ = 0; d_ < 4; ++d_) for (int r = 0; r < 16; ++r) o[d_][r] *= al_l[crow(r, hi)]; } } while (0)
    for (int g = wid; g < ngroups; g += NW) {
        const int ri = g * 32 + r32;
        const unsigned e = CAUSAL ? ((unsigned)(jblk * 256 + ri) | (3u << 16)) : lst[ri < cnt ? ri : g * 32];
        const bf16_t* qrow = Qb + (size_t)(e & 0xffffu) * PW;
        bf16x8 qr[8];
#pragma unroll
        for (int d0 = 0; d0 < 8; ++d0) qr[d0] = *(const bf16x8*)(qrow + d0 * 16 + hi * 8);
        if (hi == 0) en_l[r32] = e;
        const int qm = ri - 4 * hi;
        float m_reg = -1e30f, l_reg = 0.f; f32x16 o[4] = {};
        f32x16 pA0, pA1, pB0, pB1; float mnA, mnB, alA, alB; bf16x8 pa0, pa1, pa2, pa3;
#define MSK(P0_, P1_, t) do { if (CAUSAL && (64 * (t) + 63 > 32 * g)) mask_tile(P0_, P1_, qm - 64 * (t), 1u << 30); } while (0)
        SBAR(); qkt<0, M_CMP>(pA0, pA1, K_lds, r32, hi, qr, true, 0, I); MSK(pA0, pA1, 0); partialSM(pA0, pA1, m_reg, mnA, alA); SBAR();
#define NEED(t) (!CAUSAL || (64 * (t) <= 32 * g + 31))
#define STEP(KB, VB, PX0, PX1, mnX, alX, PY0, PY1, alY) do {                                                                   \
            SBAR(); if (NEED(KB)) qkt<KB, M_CMP>(PX0, PX1, K_lds, r32, hi, qr, true, 64 * (KB), I);                             \
            if (NEED((KB) - 1)) finishSM(PY0, PY1, alY, l_reg, pa0, pa1, pa2, pa3); SBAR();                                     \
            pv_tile<VB, true>(o, vb0, pa0, pa1, pa2, pa3, NEED((KB) - 1));                                                      \
            if (NEED(KB)) { MSK(PX0, PX1, KB); partialSM(PX0, PX1, m_reg, mnX, alX); } else alX = 1.f; SBAR();                  \
            RESC(alX); SBAR(); } while (0)
#define LAST(VB, PY0, PY1, alY) do { SBAR(); if (NEED(VB)) finishSM(PY0, PY1, alY, l_reg, pa0, pa1, pa2, pa3); SBAR(); pv_tile<VB, true>(o, vb0, pa0, pa1, pa2, pa3, NEED(VB)); SBAR(); } while (0)
        STEP(1, 0, pB0, pB1, mnB, alB, pA0, pA1, alA);
        STEP(2, 1, pA0, pA1, mnA, alA, pB0, pB1, alB);
        STEP(3, 2, pB0, pB1, mnB, alB, pA0, pA1, alA);
        LAST(3, pB0, pB1, alB);
#undef STEP
#undef LAST
#undef MSK
#undef NEED
        SBAR();
        if (hi == 0) { li_l[r32] = l_reg > 0.f ? 1.f / l_reg : 0.f; float* st = stat + ((size_t)(e & 0xffffu) * 4 + (e >> 16)) * 2; st[0] = m_reg; st[1] = l_reg; }
        asm volatile("s_waitcnt lgkmcnt(0)" ::: "memory");
        {
            float rli[16];
#pragma unroll
            for (int r = 0; r < 16; ++r) rli[r] = li_l[crow(r, hi)];
            char* stg = lds + L_STG + wid * 2048;
#pragma unroll
            for (int q = 0; q < 4; ++q) {
                stg_write(stg, o, rli, q, r32, hi);
                asm volatile("" ::: "memory");
#pragma unroll
                for (int i = 0; i < 2; ++i) { int rc, ch; const u32x4 w = stg_read(stg, i, lane, rc, ch); const unsigned eo = en_l[8 * q + rc];
                    *(u32x4*)(part + ((size_t)(eo & 0xffffu) * 4 + (eo >> 16)) * 128 + ch * 8) = w; }
                asm volatile("" ::: "memory");
            }
        }
        asm volatile("s_waitcnt lgkmcnt(0)" ::: "memory");
    }
#undef RESC
}
#undef KSWZ
}
constexpr int NWAVES = 8;
#ifndef MK_SINGLE
#define MK_SINGLE 1
#endif
#ifndef TOPK_CHECK
#define TOPK_CHECK 0
#endif
#ifndef FOX_T
#define FOX_T 32.0f
#endif
constexpr int N_PRO = 3, PH_PER_LAYER = 10, N_PHASES = N_PRO + PH_PER_LAYER * NL;

constexpr size_t MiB = 1u << 20;
constexpr size_t al256(size_t x) { return (x + 255) & ~(size_t)255; }
constexpr size_t WS_CTL = 0, CTL_ZERO_BYTES = 1 * MiB;
constexpr size_t WS_WIN = 2 * MiB;
constexpr size_t WS_WOUT = WS_WIN + (size_t)NL * NPROJ * DM * 2;
constexpr size_t WS_WUP = WS_WOUT + (size_t)NL * DM * DM * 2;
constexpr size_t WS_WDN = WS_WUP + (size_t)NL * FF * DM * 2;
constexpr size_t WS_W1T = WS_WDN + (size_t)NL * DM * FF * 2;
constexpr size_t WS_CS = WS_W1T + (size_t)NL * 2 * 256 * 4096 * 2;
constexpr size_t WS_MODP = WS_CS + (size_t)MTOK * 32 * 4;
constexpr size_t WS_MODV = WS_MODP + (size_t)NL * 32 * 2 * 12288 * 4;
constexpr size_t WS_B1P = WS_MODV + (size_t)NL * 2 * 6 * 2048 * 4;
constexpr size_t WS_B1 = WS_B1P + (size_t)NL * 2 * 64 * 256 * 4;
constexpr size_t WS_H = al256(WS_B1 + (size_t)NL * 2 * 256 * 4);
constexpr size_t WS_Y = WS_H + (size_t)MTOK * DM * 2;
constexpr size_t WS_OVL = WS_Y + (size_t)MTOK * DM * 4;
constexpr size_t WS_PROJ = WS_OVL;
constexpr size_t WS_KC = WS_PROJ + (size_t)MTOK * PW * 2;
constexpr size_t WS_VC = WS_KC + (size_t)(MTOK + 64) * 128 * 2;
constexpr size_t WS_GF = WS_VC + (size_t)(MTOK + 64) * 128 * 2;
constexpr size_t WS_CUMS = WS_GF + (size_t)MTOK * 32 * 4;
constexpr size_t WS_KMEAN = WS_CUMS + (size_t)16 * SEQ * 4;
constexpr size_t WS_QN = WS_KMEAN + (size_t)8 * 32 * 128 * 4;
constexpr size_t WS_DG = WS_QN + (size_t)16 * SEQ * 4;
constexpr size_t WS_KMX = WS_DG + (size_t)16 * SEQ * 4;
constexpr size_t WS_CPART = WS_KMX + (size_t)16 * 32 * 4 + 2048;
constexpr size_t WS_KCMP = WS_CPART + (size_t)32 * 1024 * 256 * 4;
constexpr size_t WS_VCMP = WS_KCMP + (size_t)2 * 512 * 128 * 2;
constexpr size_t WS_O = WS_VCMP + (size_t)2 * 512 * 128 * 2;
constexpr size_t WS_SCR = WS_O + (size_t)MTOK * DM * 2;
constexpr size_t WS_MLIST = WS_SCR + (size_t)256 * 2 * 256 * 128 * 4;
constexpr size_t WS_MPART = WS_MLIST + (size_t)8 * 32 * 8192 * 4;
constexpr size_t WS_MSTAT = WS_MPART + (size_t)8 * 8192 * 4 * 128 * 2;
constexpr size_t WS_OVL_END = WS_MSTAT + (size_t)8 * 8192 * 4 * 2 * 4;
constexpr size_t WS_U = WS_OVL;
constexpr size_t WS_END = (WS_OVL_END > WS_U + (size_t)MTOK * FF * 2) ? WS_OVL_END : WS_U + (size_t)MTOK * FF * 2;
constexpr int CW_ERR = 0;
constexpr int CW_BAR = 4096;
constexpr int CW_Q = 16384;
constexpr int CW_MC = 20480;
constexpr int LDS_BYTES = 163840;
constexpr int LDSCTL_OFF = 131072, MISC_OFF = LDSCTL_OFF + 320;

struct Args { const float* in[20]; float* out; unsigned char* ws; int ph_lo, ph_hi, use_bar, pad; };

struct Frame {
    LAS unsigned char* lds; char* ldsg; volatile LAS unsigned* MISC; gu32* ctl;
    int vcu, G;
    const float* x; float* out; unsigned char* ws;
};

__device__ __forceinline__ int fresh_tid() { int t = threadIdx.x; asm volatile("" : "+v"(t)); return t; }
__device__ __forceinline__ int fresh_s(int v) { asm volatile("" : "+s"(v)); return v; }
__device__ __forceinline__ unsigned char* fresh(unsigned char* p) { GAS unsigned char* g = (GAS unsigned char*)p; asm volatile("" : "+s"(g)); return (unsigned char*)g; }
__device__ __forceinline__ int proj_src_col(int n) {
    if (n < 2816) return n;
    if (n < 5888) return n + 12;
    if (n < 5900) return n - 3072;
    if (n < 5908) return n;
    return -1;
}
template <bool PROJMAP>
__device__ __forceinline__ void transpose_item(const float* W, int K, int Nsrc, int Nout, bf16_t* WT, LAS float* scr, int item, int lane) {
    const int nblk = Nout / 32, kb = item / nblk, nb = item % nblk, k0 = 64 * kb, n0 = 32 * nb;
    const int nn = n0 + (lane & 31); const int co = PROJMAP ? proj_src_col(nn) : nn;
    float tv[32];
    const float* wp = W + (size_t)(k0 + (lane >> 5)) * Nsrc + (co >= 0 ? co : 0);
#pragma unroll
    for (int i = 0; i < 32; ++i) tv[i] = wp[(size_t)(2 * i) * Nsrc];
#pragma unroll
    for (int i = 0; i < 32; ++i) scr[(2 * i + (lane >> 5)) * 33 + (lane & 31)] = (co >= 0) ? tv[i] : 0.f;
    LDS_WAIT(); asm volatile("" ::: "memory");
    const int c = lane & 7;
#pragma unroll
    for (int j = 0; j < 4; ++j) { const int n = (lane >> 3) + 8 * j; const LAS float* s = scr + (8 * c) * 33 + n;
        u32x4 o; o.x = pk2(s[0 * 33], s[1 * 33]); o.y = pk2(s[2 * 33], s[3 * 33]); o.z = pk2(s[4 * 33], s[5 * 33]); o.w = pk2(s[6 * 33], s[7 * 33]);
        *(GAS u32x4*)(WT + (size_t)(n0 + n) * K + k0 + 8 * c) = o; }
    LDS_WAIT(); asm volatile("" ::: "memory");
}

constexpr int WI_IN = (DM / 64) * (NPROJ / 32), WI_OUT = (DM / 64) * (DM / 32), WI_UP = (DM / 64) * (FF / 32), WI_DN = (FF / 64) * (DM / 32), WI_W1 = (4096 / 64) * (256 / 32);
constexpr int W_ITEMS_LAYER = WI_IN + WI_OUT + WI_UP + WI_DN + 2 * WI_W1;
__device__ __forceinline__ void weight_item(unsigned char* ws_, const Args& a, int l, int r, LAS float* scr, int lane) {
    if (r < WI_IN) { transpose_item<true>(a.in[9] + (size_t)l * DM * PROJ_DIM, DM, PROJ_DIM, NPROJ, (bf16_t*)(ws_ + WS_WIN) + (size_t)l * NPROJ * DM, scr, r, lane); return; } r -= WI_IN;
    if (r < WI_OUT) { transpose_item<false>(a.in[17] + (size_t)l * DM * DM, DM, DM, DM, (bf16_t*)(ws_ + WS_WOUT) + (size_t)l * DM * DM, scr, r, lane); return; } r -= WI_OUT;
    if (r < WI_UP) { transpose_item<false>(a.in[18] + (size_t)l * DM * FF, DM, FF, FF, (bf16_t*)(ws_ + WS_WUP) + (size_t)l * FF * DM, scr, r, lane); return; } r -= WI_UP;
    if (r < WI_DN) { transpose_item<false>(a.in[19] + (size_t)l * FF * DM, FF, DM, DM, (bf16_t*)(ws_ + WS_WDN) + (size_t)l * DM * FF, scr, r, lane); return; } r -= WI_DN;
    if (r < WI_W1) { transpose_item<false>(a.in[13] + (size_t)l * 4096 * 256, 4096, 256, 256, (bf16_t*)(ws_ + WS_W1T) + (size_t)(l * 2 + 0) * 256 * 4096, scr, r, lane); return; } r -= WI_W1;
    transpose_item<false>(a.in[15] + (size_t)l * 4096 * 256, 4096, 256, 256, (bf16_t*)(ws_ + WS_W1T) + (size_t)(l * 2 + 1) * 256 * 4096, scr, r, lane);
}

__device__ __forceinline__ void prologue_a(Frame& F, const Args& a) {
    unsigned char* const ws_ = fresh(F.ws);
    const int BID_ = fresh_s((int)blockIdx.x); (void)BID_; const int tid = fresh_tid(), lane = tid & 63, wave = __builtin_amdgcn_readfirstlane(tid >> 6); (void)lane; (void)wave;
    LAS float* scr = (LAS float*)(F.lds + wave * 16384);
    const int gw = fresh_s(F.vcu) * NWAVES + wave, NGW = F.G * NWAVES;
    for (int it = gw; it < W_ITEMS_LAYER; it += NGW) weight_item(ws_, a, 0, it, scr, lane);
    __syncthreads();
    {
        LAS float* cact = (LAS float*)(F.lds);
        float* MODP = (float*)(ws_ + WS_MODP);
        for (int it = BID_; it < NL * 32 * 6; it += F.G) {
            const int l = it / 192, kc = (it % 192) / 6, jc = it % 6, k0 = kc * 64, j = jc * 2048 + tid * 4;
            __syncthreads();
            if (tid < 128) { const int b = tid >> 6, kk = tid & 63; const float cv = a.in[1][b * DM + k0 + kk]; cact[tid] = cv / (1.f + __expf(-cv)); }
            __syncthreads();
            const float* wp = a.in[3] + ((size_t)l * DM + k0) * 12288 + j;
            f32x4 a0 = {0.f, 0.f, 0.f, 0.f}, a1 = {0.f, 0.f, 0.f, 0.f};
#pragma unroll 8
            for (int kk = 0; kk < 64; ++kk) { const f32x4 w = *(const f32x4*)(wp + (size_t)kk * 12288); a0 += cact[kk] * w; a1 += cact[64 + kk] * w; }
            *(f32x4*)(MODP + ((size_t)(l * 32 + kc) * 2 + 0) * 12288 + j) = a0;
            *(f32x4*)(MODP + ((size_t)(l * 32 + kc) * 2 + 1) * 12288 + j) = a1;
        }
        __syncthreads();
    }
    {
        _Float16* CS = (_Float16*)(ws_ + WS_CS); const int* posi = (const int*)a.in[2];
        for (int i = BID_ * 512 + tid; i < MTOK * 16; i += F.G * 512) { const int m = i >> 4, d = i & 15;
            const float inv = powf(500000.0f, -(float)d / 16.0f); const float ang = (float)posi[m] * inv; float sn, cs; sincosf(ang, &sn, &cs);
            CS[(size_t)m * 32 + d] = (_Float16)cs; CS[(size_t)m * 32 + 16 + d] = (_Float16)sn; }
    }
    {
        float* B1P = (float*)(ws_ + WS_B1P);
        for (int it = BID_ * 2 + (tid >> 8); it < NL * 2 * 64; it += F.G * 2) {
            const int lk = it >> 6, kc = it & 63, l = lk >> 1, kv = lk & 1, j = tid & 255;
            const float* pe = a.in[kv ? 12 : 11] + (size_t)l * 4096 + kc * 64; const float* w1 = a.in[kv ? 15 : 13] + ((size_t)l * 4096 + kc * 64) * 256 + j;
            float wv[64];
#pragma unroll
            for (int kk = 0; kk < 64; ++kk) wv[kk] = w1[(size_t)kk * 256];
            float acc = 0.f;
#pragma unroll
            for (int kk = 0; kk < 64; ++kk) acc += pe[kk] * wv[kk];
            B1P[(size_t)it * 256 + j] = acc;
        }
    }
}
__device__ __forceinline__ void prologue_b(Frame& F, const Args& a) {
    unsigned char* const ws_ = fresh(F.ws);
    const int BID_ = fresh_s((int)blockIdx.x); (void)BID_; const int tid = fresh_tid(), lane = tid & 63, wave = __builtin_amdgcn_readfirstlane(tid >> 6); (void)lane; (void)wave;
    const float* MODP = (const float*)(ws_ + WS_MODP); float* MODV = (float*)(ws_ + WS_MODV);
    for (int i = BID_ * 512 + tid; i < NL * 2 * 6 * 2048; i += F.G * 512) {
        const int e = i & 2047, v = (i >> 11) % 6, b = (i / (6 * 2048)) & 1, l = i / (2 * 6 * 2048);
        const int chunk = (v == 0) ? 1 : (v == 1) ? 0 : (v == 2) ? 2 : (v == 3) ? 4 : (v == 4) ? 3 : 5;
        const int j = chunk * 2048 + e;
        float s = a.in[4][(size_t)l * 12288 + j];
        for (int kc = 0; kc < 32; ++kc) s += MODP[((size_t)(l * 32 + kc) * 2 + b) * 12288 + j];
        float r;
        if (v == 0) r = a.in[5][l * DM + e] * (1.f + s);
        else if (v == 1) r = s;
        else if (v == 2) r = a.in[6][l * DM + e] * s;
        else if (v == 3) r = a.in[7][l * DM + e] * (1.f + s);
        else if (v == 4) r = s;
        else r = a.in[8][l * DM + e] * s;
        MODV[i] = r;
    }
    const float* B1P = (const float*)(ws_ + WS_B1P); float* B1 = (float*)(ws_ + WS_B1);
    for (int i = BID_ * 512 + tid; i < NL * 2 * 256; i += F.G * 512) { const int lk = i >> 8, j = i & 255; float s = 0.f;
        for (int kc = 0; kc < 64; ++kc) s += B1P[((size_t)lk * 64 + kc) * 256 + j];
        B1[i] = s; }
}

template <int KIND, bool SHADOW = false>
__device__ __forceinline__ void norm_phase(Frame& F, int l) {
    unsigned char* const ws_ = fresh(F.ws);
    const int tid = fresh_tid(), lane = tid & 63, wave = __builtin_amdgcn_readfirstlane(tid >> 6);
    const int gw = fresh_s(F.vcu) * NWAVES + wave, NGW = F.G * NWAVES;
    const int rpw = (MTOK + NGW - 1) / NGW;
    const float* MODV = (const float*)(ws_ + WS_MODV); const bf16_t* Y = (const bf16_t*)(ws_ + WS_Y); bf16_t* H = SHADOW ? (bf16_t*)(ws_ + WS_PROJ + (size_t)MTOK * DM * 4) : (bf16_t*)(ws_ + WS_H);
    bf16_t* XB = (bf16_t*)(ws_ + WS_Y + (size_t)MTOK * DM * 2);
    const bool in_f32 = (KIND == 0) || (KIND == 1 && l == 0), out_f32 = (KIND == 2 && l == NL - 1);
    int mend = (gw + 1) * rpw; if (mend > MTOK) mend = MTOK;
    const bool do_h = !(KIND == 2 && l == NL - 1);
    const int lv = (KIND == 2 && l + 1 < NL) ? l + 1 : l;
    f32x4 gv[8], av[8], sv[8]; int bcur = -1;
    f32x4 xf[8]; u32x2 xr2[8], yr2[8];
#define NP_LOAD(mm) do { if (in_f32) { const f32x4* xr = (const f32x4*)(F.x + (size_t)(mm) * DM) + lane; _Pragma("unroll") for (int j = 0; j < 8; ++j) xf[j] = xr[64 * j]; }              \
        else { const u32x2* xr = (const u32x2*)(XB + (size_t)(mm) * DM) + lane; _Pragma("unroll") for (int j = 0; j < 8; ++j) xr2[j] = xr[64 * j]; }                                       \
        if (KIND != 0) { const u32x2* yr = (const u32x2*)(Y + (size_t)(mm) * DM) + lane; _Pragma("unroll") for (int j = 0; j < 8; ++j) yr2[j] = yr[64 * j]; } } while (0)
    if (gw * rpw < mend) NP_LOAD(gw * rpw);
    for (int m = gw * rpw; m < mend; ++m) {
        const int b = m / SEQ;
        if (b != bcur) { bcur = b;
            const f32x4* gp = (const f32x4*)(MODV + ((size_t)(l * 2 + b) * 6 + (KIND == 1 ? 2 : 5)) * DM) + lane;
            const f32x4* ap = (const f32x4*)(MODV + ((size_t)(lv * 2 + b) * 6 + (KIND == 1 ? 3 : 0)) * DM) + lane;
            const f32x4* sp = (const f32x4*)(MODV + ((size_t)(lv * 2 + b) * 6 + (KIND == 1 ? 4 : 1)) * DM) + lane;
#pragma unroll
            for (int j = 0; j < 8; ++j) { if (KIND != 0) gv[j] = gp[64 * j]; av[j] = ap[64 * j]; sv[j] = sp[64 * j]; } }
        f32x4 xv[8], yv[8];
#pragma unroll
        for (int j = 0; j < 8; ++j) {
            if (in_f32) xv[j] = xf[j];
            else xv[j] = (f32x4){__builtin_bit_cast(float, xr2[j].x << 16), __builtin_bit_cast(float, xr2[j].x & 0xffff0000u), __builtin_bit_cast(float, xr2[j].y << 16), __builtin_bit_cast(float, xr2[j].y & 0xffff0000u)};
            if (KIND != 0) yv[j] = (f32x4){__builtin_bit_cast(float, yr2[j].x << 16), __builtin_bit_cast(float, yr2[j].x & 0xffff0000u), __builtin_bit_cast(float, yr2[j].y << 16), __builtin_bit_cast(float, yr2[j].y & 0xffff0000u)}; }
        if (m + 1 < mend) NP_LOAD(m + 1);
        if (KIND != 0) {
            float ss = 0.f;
#pragma unroll
            for (int j = 0; j < 8; ++j) ss += (yv[j].x * yv[j].x + yv[j].y * yv[j].y) + (yv[j].z * yv[j].z + yv[j].w * yv[j].w);
            const float rs = 1.f / sqrtf(wave_sum(ss) * (1.f / DM) + NORM_EPS);
#pragma unroll
            for (int j = 0; j < 8; ++j) xv[j] = xv[j] + (yv[j] * rs) * gv[j];
            if (out_f32) { f32x4* xo = (f32x4*)(F.out + (size_t)m * DM) + lane;
#pragma unroll
                for (int j = 0; j < 8; ++j) xo[64 * j] = xv[j]; }
            else { u32x2* xo = (u32x2*)(XB + (size_t)m * DM) + lane;
#pragma unroll
                for (int j = 0; j < 8; ++j) { u32x2 w; w.x = cvtpk(xv[j].x, xv[j].y); w.y = cvtpk(xv[j].z, xv[j].w); xo[64 * j] = w; } }
        }
        if (!do_h) continue;
        float ss = 0.f;
#pragma unroll
        for (int j = 0; j < 8; ++j) ss += (xv[j].x * xv[j].x + xv[j].y * xv[j].y) + (xv[j].z * xv[j].z + xv[j].w * xv[j].w);
        const float rs = 1.f / sqrtf(wave_sum(ss) * (1.f / DM) + NORM_EPS);
        u32x2* ho = (u32x2*)(H + (size_t)m * DM) + lane;
#pragma unroll
        for (int j = 0; j < 8; ++j) { const f32x4 hv = (xv[j] * rs) * av[j] + sv[j]; u32x2 w; w.x = cvtpk(hv.x, hv.y); w.y = cvtpk(hv.z, hv.w); ho[64 * j] = w; }
    }
#undef NP_LOAD
}

__device__ __forceinline__ void kmean_item(Frame& F, int it) {
    unsigned char* const ws_ = fresh(F.ws);
    const int BID_ = fresh_s((int)blockIdx.x); (void)BID_; const int tid = fresh_tid(), lane = tid & 63, wave = __builtin_amdgcn_readfirstlane(tid >> 6); (void)lane; (void)wave;
    const int blk = it & 31, bh = it >> 5, b = bh >> 2, h = bh & 3;
    const bf16_t* Kp = (const bf16_t*)(ws_ + WS_PROJ) + ((size_t)b * SEQ + blk * 256) * PW + C_MK + h * 128;
    LAS float* red = (LAS float*)F.lds;
    const int kq = tid >> 4, dc = (tid & 15) * 8;
    float acc[8] = {0.f, 0.f, 0.f, 0.f, 0.f, 0.f, 0.f, 0.f};
    for (int i = 0; i < 8; ++i) { const bf16x8 v = *(const bf16x8*)(Kp + (size_t)(kq * 8 + i) * PW + dc);
#pragma unroll
        for (int j = 0; j < 8; ++j) acc[j] += bf2f((unsigned short)v[j]); }
    __syncthreads();
#pragma unroll
    for (int j = 0; j < 8; ++j) red[kq * 128 + dc + j] = acc[j];
    __syncthreads();
    if (tid < 128) { float s = 0.f; for (int q = 0; q < 32; ++q) s += red[q * 128 + tid];
        ((float*)(ws_ + WS_KMEAN))[(size_t)it * 128 + tid] = s * (1.f / 256.f); }
}
__device__ __forceinline__ void cumsum_item(Frame& F, int bh) {
    unsigned char* const ws_ = fresh(F.ws);
    const int tid = fresh_tid(), lane = tid & 63, wave = __builtin_amdgcn_readfirstlane(tid >> 6);
    const int b = bh >> 3, h = bh & 7;
    const float* gf = (const float*)(ws_ + WS_GF) + (size_t)b * SEQ * 32 + 12 + h;
    LAS float* tot = (LAS float*)F.lds;
    float v[16];
#pragma unroll
    for (int i = 0; i < 16; ++i) v[i] = gf[(size_t)(tid * 16 + i) * 32];
#pragma unroll
    for (int i = 1; i < 16; ++i) v[i] += v[i - 1];
    float inc = v[15];
#pragma unroll
    for (int o = 1; o < 64; o <<= 1) { const float u = __shfl_up(inc, o); if (lane >= o) inc += u; }
    __syncthreads();
    if (lane == 63) tot[wave] = inc;
    __syncthreads();
    float off = inc - v[15];
    for (int w = 0; w < wave; ++w) off += tot[w];
    float* out = (float*)(ws_ + WS_CUMS) + (size_t)bh * SEQ + tid * 16;
    constexpr float INVS = 11.313708498984761f;
#pragma unroll
    for (int i = 0; i < 16; ++i) out[i] = (off + v[i]) * INVS;
    __syncthreads();
}
__device__ __forceinline__ void foxnorm_item(Frame& F, int it) {
    unsigned char* const ws_ = fresh(F.ws);
    const int tid = fresh_tid();
    const int qb = it & 31, bh = it >> 5, b = bh >> 3, h = bh & 7;
    const bf16_t* P = (const bf16_t*)(ws_ + WS_PROJ); const size_t m0 = (size_t)b * SEQ + qb * 256;
    LAS float* red = (LAS float*)F.lds;
    float kn = 0.f;
    if (tid < 256) {
        const bf16_t* qrow = P + (m0 + tid) * PW + C_FQ + h * 128; const bf16_t* krow = P + (m0 + tid) * PW + C_FK + h * 128;
        float qq = 0.f, kk = 0.f, qk = 0.f;
#pragma unroll
        for (int c = 0; c < 16; ++c) { const bf16x8 qv = *(const bf16x8*)(qrow + c * 8), kv = *(const bf16x8*)(krow + c * 8);
#pragma unroll
            for (int j = 0; j < 8; ++j) { const float a = bf2f((unsigned short)qv[j]), k = bf2f((unsigned short)kv[j]); qq = fmaf(a, a, qq); kk = fmaf(k, k, kk); qk = fmaf(a, k, qk); } }
        ((float*)(ws_ + WS_QN))[(size_t)bh * SEQ + qb * 256 + tid] = sqrtf(qq);
        ((float*)(ws_ + WS_DG))[(size_t)bh * SEQ + qb * 256 + tid] = qk * SM_SCALE;
        kn = sqrtf(kk);
    }
#pragma unroll
    for (int o = 1; o < 64; o <<= 1) kn = fmaxf(kn, __shfl_xor(kn, o));
    __syncthreads();
    if ((tid & 63) == 0) red[tid >> 6] = kn;
    __syncthreads();
    if (tid == 0) { float m = red[0]; for (int w = 1; w < 8; ++w) m = fmaxf(m, red[w]); ((float*)(ws_ + WS_KMX))[it] = m; }
    __syncthreads();
}
__device__ __forceinline__ void cmp_stage2_item(Frame& F, const Args& a, int l, int it) {
    unsigned char* const ws_ = fresh(F.ws);
    const int BID_ = fresh_s((int)blockIdx.x); (void)BID_; const int tid = fresh_tid(), lane = tid & 63, wave = __builtin_amdgcn_readfirstlane(tid >> 6); (void)lane; (void)wave;
    const int kv = it >> 7, r0 = (it & 127) * 8;
    const float* CP = (const float*)(ws_ + WS_CPART) + (size_t)kv * 16 * 1024 * 256; const float* B1 = (const float*)(ws_ + WS_B1) + (size_t)(l * 2 + kv) * 256;
    LAS float* h1 = (LAS float*)F.lds;
    const int row = tid >> 6, c4 = (tid & 63) * 4;
    f32x4 s = *(const f32x4*)(B1 + c4);
    for (int ks = 0; ks < 16; ++ks) s += *(const f32x4*)(CP + ((size_t)ks * 1024 + r0 + row) * 256 + c4);
    __syncthreads();
#pragma unroll
    for (int j = 0; j < 4; ++j) { const float x = s[j]; const float u = 0.7978845608028654f * (x + 0.044715f * x * x * x); h1[row * 256 + c4 + j] = 0.5f * x * (1.f + tanhf(u)); }
    __syncthreads();
    const int oc = (tid & 63) * 2, ks = __builtin_amdgcn_readfirstlane(tid >> 6); const float* w2 = a.in[kv ? 16 : 14] + ((size_t)l * 256 + ks * 32) * 128 + oc;
    f32x2 wv[32];
#pragma unroll
    for (int k = 0; k < 32; ++k) wv[k] = *(const f32x2*)(w2 + (size_t)k * 128);
    LAS float* part = h1 + 8 * 256;
#pragma unroll
    for (int r = 0; r < 8; ++r) { float p0 = 0.f, p1 = 0.f;
#pragma unroll
        for (int k4 = 0; k4 < 8; ++k4) { const f32x4 hv = *(const LAS f32x4*)(h1 + r * 256 + ks * 32 + k4 * 4);
            p0 += hv.x * wv[4 * k4].x + hv.y * wv[4 * k4 + 1].x + hv.z * wv[4 * k4 + 2].x + hv.w * wv[4 * k4 + 3].x;
            p1 += hv.x * wv[4 * k4].y + hv.y * wv[4 * k4 + 1].y + hv.z * wv[4 * k4 + 2].y + hv.w * wv[4 * k4 + 3].y; }
        *(LAS f32x2*)(part + (ks * 8 + r) * 128 + oc) = (f32x2){p0, p1}; }
    __syncthreads();
    float o0 = 0.f, o1 = 0.f;
#pragma unroll
    for (int s8 = 0; s8 < 8; ++s8) { const f32x2 pv = *(const LAS f32x2*)(part + (s8 * 8 + row) * 128 + oc); o0 += pv.x; o1 += pv.y; }
    const int gr = r0 + row;
    if ((gr & 511) == 511) { o0 = 0.f; o1 = 0.f; }
    bf16_t* dst = (bf16_t*)(ws_ + (kv ? WS_VCMP : WS_KCMP)) + (size_t)gr * 128 + oc;
    *(unsigned*)dst = cvtpk(o0, o1);
    __syncthreads();
}

__device__ __forceinline__ void fox_item(Frame& F, int b, int h, int qb) {
    unsigned char* const ws_ = fresh(F.ws);
    const int tid = fresh_tid(), lane = tid & 63, wave = __builtin_amdgcn_readfirstlane(tid >> 6);
    float* auxf = (float*)(F.ldsg + att::L_AUX); const int bh = b * 8 + h; const float* cs = (const float*)(ws_ + WS_CUMS) + (size_t)bh * SEQ;
    float* redf = (float*)(F.ldsg + att::L_BITS);
    int jlo, wjlo;
    {
        const float* kmx = (const float*)(ws_ + WS_KMX) + bh * 32;
        float kg = (lane <= qb) ? kmx[lane] : 0.f;
        float qn = 0.f, dg = 0.f;
        if (tid < 256) { qn = ((const float*)(ws_ + WS_QN))[(size_t)bh * SEQ + qb * 256 + tid]; dg = ((const float*)(ws_ + WS_DG))[(size_t)bh * SEQ + qb * 256 + tid]; }
        const float c0s = cs[qb * 256];
        const float c0 = c0s * SM_SCALE, c0w = cs[qb * 256 + 32 * wave] * SM_SCALE;
        const bool t0v = lane < 4 * qb, t1v = lane + 64 < 4 * qb;
        const float ce0 = cs[(t0v ? lane : 0) * 64 + 63] * SM_SCALE, ce1 = cs[(t1v ? lane + 64 : 0) * 64 + 63] * SM_SCALE;
        for (int i = tid; i < (qb + 1) * 64; i += 512) ((f32x4*)auxf)[i] = c0s - ((const f32x4*)cs)[i];
#pragma unroll
        for (int o = 1; o < 64; o <<= 1) kg = fmaxf(kg, __shfl_xor(kg, o));
        float a = (tid < 256) ? qn * kg * SM_SCALE - dg : -3e38f;
#pragma unroll
        for (int o = 1; o < 32; o <<= 1) a = fmaxf(a, __shfl_xor(a, o));
        if ((lane & 31) == 0 && tid < 256) redf[tid >> 5] = a;
        __syncthreads();
        const float Aw = redf[wave];
        float A = redf[0];
#pragma unroll
        for (int w = 1; w < 8; ++w) A = fmaxf(A, redf[w]);
        const bool k0_ = !t0v || (A + c0 - ce0) >= -FOX_T, w0_ = !t0v || (Aw + c0w - ce0) >= -FOX_T;
        const bool k1_ = !t1v || (A + c0 - ce1) >= -FOX_T, w1_ = !t1v || (Aw + c0w - ce1) >= -FOX_T;
        const unsigned long long km0 = __ballot(k0_), km1 = __ballot(k1_), wm0 = __ballot(w0_), wm1 = __ballot(w1_);
        jlo = km0 ? (int)__builtin_ctzll(km0) : 64 + (int)__builtin_ctzll(km1);
        wjlo = wm0 ? (int)__builtin_ctzll(wm0) : 64 + (int)__builtin_ctzll(wm1);
        if (jlo > 4 * qb) jlo = 4 * qb;
        if (wjlo > 4 * qb) wjlo = 4 * qb;
        jlo = __builtin_amdgcn_readfirstlane(jlo); wjlo = __builtin_amdgcn_readfirstlane(wjlo);
        __syncthreads();
    }
    const bf16_t* P = (const bf16_t*)(ws_ + WS_PROJ); const size_t m0 = (size_t)b * SEQ + qb * 256;
    att::Ref R{P + m0 * PW + C_FQ + h * 128, P + (size_t)b * SEQ * PW + C_FK + h * 128, P + (size_t)b * SEQ * PW + C_FV + h * 128, PW, qb * 256, SEQ, jlo};
    att::Out E{(bf16_t*)(ws_ + WS_O) + m0 * DM + O_FOX + h * 128, nullptr, nullptr, 0};
    bf16x8 qr[8]; float mo, lo;
    att::attn_pass<att::M_FOX, true>(R, F.ldsg, qr, E, mo, lo, (unsigned long long)wjlo, 0ull);
}
__device__ __forceinline__ void moba_gate_item(Frame& F, int l, int it) {
    unsigned char* const ws_ = fresh(F.ws);
    const int tid = fresh_tid();
    const int qb = it & 31, bh = it >> 5, b = bh >> 2, h = bh & 3;
    if (qb == 0) return;
    float* auxf = (float*)(F.ldsg + att::L_AUX);
    const bf16_t* P = (const bf16_t*)(ws_ + WS_PROJ); const size_t m0 = (size_t)b * SEQ + qb * 256;
    const float* km = (const float*)(ws_ + WS_KMEAN) + (size_t)bh * 32 * 128;
    const int row = tid >> 1, half = tid & 1;
    const bf16_t* qrow = P + (m0 + row) * PW + C_MQ + h * 128 + half * 64;
    bf16x8 qraw[8];
#pragma unroll
    for (int c = 0; c < 8; ++c) qraw[c] = *(const bf16x8*)(qrow + c * 8);
    __syncthreads();
    for (int i = tid; i < qb * 32; i += 512) ((f32x4*)auxf)[i] = ((const f32x4*)km)[i];
    __syncthreads();
    {
        f32x4 q[16];
#pragma unroll
        for (int c = 0; c < 8; ++c) { const bf16x8 v = qraw[c];
            q[2 * c] = (f32x4){bf2f((unsigned short)v[0]), bf2f((unsigned short)v[1]), bf2f((unsigned short)v[2]), bf2f((unsigned short)v[3])};
            q[2 * c + 1] = (f32x4){bf2f((unsigned short)v[4]), bf2f((unsigned short)v[5]), bf2f((unsigned short)v[6]), bf2f((unsigned short)v[7])}; }
        float b0 = -3e38f, b1 = -3e38f, b2 = -3e38f; int i0 = -1, i1 = -1, i2 = -1;
        for (int n = 0; n < qb; ++n) {
            const f32x4* kmr = (const f32x4*)(auxf + n * 128 + half * 64);
            f32x4 a4 = {0.f, 0.f, 0.f, 0.f};
#pragma unroll
            for (int c = 0; c < 16; ++c) a4 += q[c] * kmr[c];
            float g = (a4.x + a4.y) + (a4.z + a4.w);
            g += __shfl_xor(g, 1);
            if (g > b0) { b2 = b1; i2 = i1; b1 = b0; i1 = i0; b0 = g; i0 = n; }
            else if (g > b1) { b2 = b1; i2 = i1; b1 = g; i1 = n; }
            else if (g > b2) { b2 = g; i2 = n; }
        }
        unsigned* lc = (unsigned*)(F.ldsg + att::L_BITS);
        __syncthreads();
        if (tid < 64) lc[tid] = 0u;
        __syncthreads();
        unsigned r0 = 0, r1 = 0, r2 = 0;
        if (half == 0) { if (i0 >= 0) r0 = atomicAdd(&lc[i0], 1u); if (i1 >= 0) r1 = atomicAdd(&lc[i1], 1u); if (i2 >= 0) r2 = atomicAdd(&lc[i2], 1u); }
        __syncthreads();
        if (tid < qb) { const unsigned c = lc[tid]; lc[32 + tid] = c ? __hip_atomic_fetch_add(F.ctl + CW_MC + ((l * 8 + bh) * 32 + tid) * 64, c, RLX_AGENT) : 0u; }
        __syncthreads();
        if (half == 0) {
            unsigned* lst = (unsigned*)(ws_ + WS_MLIST) + (size_t)bh * 32 * 8192;
            const unsigned tok = (unsigned)(qb * 256 + row);
            if (i0 >= 0) lst[(size_t)i0 * 8192 + lc[32 + i0] + r0] = tok;
            if (i1 >= 0) lst[(size_t)i1 * 8192 + lc[32 + i1] + r1] = tok | (1u << 16);
            if (i2 >= 0) lst[(size_t)i2 * 8192 + lc[32 + i2] + r2] = tok | (2u << 16);
        }
    }
}
__device__ __forceinline__ void moba_blk_item(Frame& F, int l, int bh, int j, bool own) {
    unsigned char* const ws_ = fresh(F.ws);
    const int b = bh >> 2, h = bh & 3;
    const bf16_t* P = (const bf16_t*)(ws_ + WS_PROJ) + (size_t)b * SEQ * PW;
    att::moba_block_load(P + (size_t)j * 256 * PW + C_MK + h * 128, P + (size_t)j * 256 * PW + C_MV + h * 128, F.ldsg);
    bf16_t* part = (bf16_t*)(ws_ + WS_MPART) + (size_t)bh * 8192 * 4 * 128; float* stat = (float*)(ws_ + WS_MSTAT) + (size_t)bh * 8192 * 4 * 2;
    if (own) att::moba_block_groups<true>(P + C_MQ + h * 128, nullptr, 256, j, part, stat, F.ldsg);
    else { const int cnt = __builtin_amdgcn_readfirstlane((int)__hip_atomic_load(F.ctl + CW_MC + (l * 256 + bh * 32 + j) * 64, RLX_AGENT));
        att::moba_block_groups<false>(P + C_MQ + h * 128, (const unsigned*)(ws_ + WS_MLIST) + ((size_t)bh * 32 + j) * 8192, cnt, j, part, stat, F.ldsg); }
}
__device__ __forceinline__ void moba_combine(Frame& F) {
    unsigned char* const ws_ = fresh(F.ws);
    const int tid = fresh_tid();
    const int BID_ = fresh_s((int)blockIdx.x);
    const bf16_t* part = (const bf16_t*)(ws_ + WS_MPART); const float* stat = (const float*)(ws_ + WS_MSTAT); bf16_t* O = (bf16_t*)(ws_ + WS_O);
    constexpr float C2 = 1.4426950408889634f * SM_SCALE;
    const int c8 = (tid & 15) * 8; const int rstep = F.G * 32; int row = BID_ * 32 + (tid >> 4);
    f32x4 sa, sb; bf16x8 pv[4];
#define MC_LOAD(r_) do { const float* st_ = stat + (size_t)(r_) * 8; sa = *(const f32x4*)st_; sb = *(const f32x4*)(st_ + 4);                                   \
        _Pragma("unroll") for (int k = 0; k < 4; ++k) pv[k] = *(const bf16x8*)(part + ((size_t)(r_) * 4 + k) * 128 + c8); } while (0)
    if (row < 8 * 8192) MC_LOAD(row);
    for (; row < 8 * 8192; row += rstep) {
        const int bh = row >> 13, t = row & 8191, b = bh >> 2, h = bh & 3;
        const int nsel = (t >> 8) < 3 ? (t >> 8) : 3;
        const float st[8] = {sa.x, sa.y, sa.z, sa.w, sb.x, sb.y, sb.z, sb.w};
        bf16x8 v4[4];
#pragma unroll
        for (int k = 0; k < 4; ++k) v4[k] = pv[k];
        if (row + rstep < 8 * 8192) MC_LOAD(row + rstep);
        float m[4], lw[4]; float M = st[6];
#pragma unroll
        for (int k = 0; k < 3; ++k) { m[k] = (k < nsel) ? st[2 * k] : -3e38f; lw[k] = (k < nsel) ? st[2 * k + 1] : 0.f; M = fmaxf(M, m[k]); }
        m[3] = st[6]; lw[3] = st[7];
        float acc[8] = {0.f, 0.f, 0.f, 0.f, 0.f, 0.f, 0.f, 0.f}; float den = 0.f;
#pragma unroll
        for (int k = 0; k < 4; ++k) { if (k < 3 && k >= nsel) continue;
            const float w = lw[k] * __builtin_amdgcn_exp2f((m[k] - M) * C2); den += w;
            const bf16x8 v = v4[k];
#pragma unroll
            for (int jj = 0; jj < 8; ++jj) acc[jj] = fmaf(w, bf2f((unsigned short)v[jj]), acc[jj]); }
        const float inv = 1.f / den;
        u32x4 w4; w4.x = cvtpk(acc[0] * inv, acc[1] * inv); w4.y = cvtpk(acc[2] * inv, acc[3] * inv); w4.z = cvtpk(acc[4] * inv, acc[5] * inv); w4.w = cvtpk(acc[6] * inv, acc[7] * inv);
        *(u32x4*)(O + ((size_t)b * SEQ + t) * DM + O_MOBA + h * 128 + c8) = w4;
    }
#undef MC_LOAD
}
__device__ __forceinline__ void nsa_item(Frame& F, int b, int tb) {
    unsigned char* const ws_ = fresh(F.ws);
    const int BID_ = fresh_s((int)blockIdx.x); (void)BID_; const int tid = fresh_tid(), lane = tid & 63, wave = __builtin_amdgcn_readfirstlane(tid >> 6); (void)lane; (void)wave;
    float* imp = (float*)(F.ldsg + att::L_AUX); unsigned* bits = (unsigned*)(F.ldsg + att::L_BITS);
    const bf16_t* P = (const bf16_t*)(ws_ + WS_PROJ); const int P0 = tb * 64; const size_t m0 = (size_t)b * SEQ + P0;
    { float z = 0.f; asm volatile("" : "+v"(z)); const f32x4 zz = {z, z, z, z};
      for (int i = tid; i < 2048; i += 512) ((f32x4*)imp)[i] = zz; }
    __syncthreads();
    float* scr = (float*)(ws_ + WS_SCR) + (size_t)BID_ * 2 * 256 * 128;
    const float* gf = (const float*)(ws_ + WS_GF) + m0 * 32;
    bf16_t* Ob = (bf16_t*)(ws_ + WS_O) + m0 * DM + O_NSA;
    const bf16_t* Kc = (const bf16_t*)(ws_ + WS_KCMP) + (size_t)b * 512 * 128; const bf16_t* Vc = (const bf16_t*)(ws_ + WS_VCMP) + (size_t)b * 512 * 128;
    bf16x8 qr[8]; float mo, lo;
    {
        att::Ref R{P + m0 * PW + C_NQ, Kc, Vc, 128, P0, NCMPP, 0};
        att::Out E{Ob, scr, gf, 0};
        att::attn_pass<att::M_CMP, true>(R, F.ldsg, qr, E, mo, lo, 0ull, 0ull);
        att::cmp_imp_pass(Kc, P0, F.ldsg, qr, mo, lo);
    }
    {
        const int cur = tb, nforced = cur == 0 ? 1 : (cur == 1 ? 2 : 3), nrest = 16 - nforced;
        const int n0 = lane, n1 = lane + 64;
        const bool cand0 = (n0 >= 1 && n0 <= cur - 2), cand1 = (n1 <= cur - 2);
        const bool f0 = (n0 == 0 || n0 == cur || n0 == cur - 1), f1 = (n1 == cur || n1 == cur - 1);
        for (int q = 0; q < 8; q += 2) {
            const int tka = 8 * wave + q, tkb = tka + 1; const float* ira = imp + tka * 128; const float* irb = imp + tkb * 128;
            const unsigned ba0 = __float_as_uint(ira[lane]), ba1 = __float_as_uint(ira[lane + 64]), bb0 = __float_as_uint(irb[lane]), bb1 = __float_as_uint(irb[lane + 64]);
            const unsigned ka0 = cand0 ? ba0 : 0u, ka1 = cand1 ? ba1 : 0u, kb0 = cand0 ? bb0 : 0u, kb1 = cand1 ? bb1 : 0u;
            unsigned Ta = 0u, Tb = 0u;
#pragma unroll 1
            for (int b = 30; b >= 0; --b) {
                const unsigned ta = Ta | (1u << b), tb2 = Tb | (1u << b);
                const int ca = __builtin_popcountll(__ballot(ka0 >= ta)) + __builtin_popcountll(__ballot(ka1 >= ta));
                const int cb = __builtin_popcountll(__ballot(kb0 >= tb2)) + __builtin_popcountll(__ballot(kb1 >= tb2));
                if (ca >= nrest) Ta = ta;
                if (cb >= nrest) Tb = tb2;
            }
#define NSA_PICK(T_, k0_, k1_, tk_) do {                                                                                          \
                const bool g0 = (k0_) > (T_), g1 = (k1_) > (T_);                                                                  \
                const int need = nrest - (__builtin_popcountll(__ballot(g0)) + __builtin_popcountll(__ballot(g1)));               \
                const bool e0 = cand0 && (k0_) == (T_), e1 = cand1 && (k1_) == (T_);                                              \
                const unsigned long long me0 = __ballot(e0), me1 = __ballot(e1);                                                  \
                const int rk0 = (int)__builtin_amdgcn_mbcnt_hi((unsigned)(me0 >> 32), __builtin_amdgcn_mbcnt_lo((unsigned)me0, 0u));   \
                const int rk1 = __builtin_popcountll(me0) + (int)__builtin_amdgcn_mbcnt_hi((unsigned)(me1 >> 32), __builtin_amdgcn_mbcnt_lo((unsigned)me1, 0u)); \
                const bool s0 = n0 <= cur && (f0 || g0 || (e0 && rk0 < need)), s1 = n1 <= cur && (f1 || g1 || (e1 && rk1 < need));  \
                const unsigned long long m0b = __ballot(s0), m1b = __ballot(s1);                                                  \
                if (lane == 0) { bits[(tk_) * 4 + 0] = (unsigned)m0b; bits[(tk_) * 4 + 1] = (unsigned)(m0b >> 32); bits[(tk_) * 4 + 2] = (unsigned)m1b; bits[(tk_) * 4 + 3] = (unsigned)(m1b >> 32); } } while (0)
            NSA_PICK(Ta, ka0, ka1, tka); NSA_PICK(Tb, kb0, kb1, tkb);
#undef NSA_PICK
#if TOPK_CHECK
            for (int w2 = 0; w2 < 2; ++w2) { const int tk = w2 ? tkb : tka; const float* ir = imp + tk * 128;
                const float v0 = ir[lane], v1 = ir[lane + 64]; int r0 = 0, r1 = 0;
                for (int m = 1; m <= cur - 2; ++m) { const float xv = ir[m];
                    r0 += (xv > v0 || (xv == v0 && m < lane)) ? 1 : 0; r1 += (xv > v1 || (xv == v1 && m < lane + 64)) ? 1 : 0; }
                const bool s0 = n0 <= cur && (f0 || r0 < nrest), s1 = n1 <= cur && (f1 || r1 < nrest);
                const unsigned long long m0b = __ballot(s0), m1b = __ballot(s1);
                asm volatile("s_waitcnt lgkmcnt(0)" ::: "memory");
                if (lane == 0 && (bits[tk * 4 + 0] != (unsigned)m0b || bits[tk * 4 + 1] != (unsigned)(m0b >> 32) || bits[tk * 4 + 2] != (unsigned)m1b || bits[tk * 4 + 3] != (unsigned)(m1b >> 32))) F.MISC[20] = 1u; }
#endif
        }
        __syncthreads();
    }
    unsigned long long wlo, whi;
    {
        unsigned v = (lane < 32) ? bits[(8 * wave + (lane >> 2)) * 4 + (lane & 3)] : 0u;
        v |= __shfl_xor(v, 4); v |= __shfl_xor(v, 8); v |= __shfl_xor(v, 16);
        const unsigned w0 = __builtin_amdgcn_readlane(v, 0), w1 = __builtin_amdgcn_readlane(v, 1), w2 = __builtin_amdgcn_readlane(v, 2), w3 = __builtin_amdgcn_readlane(v, 3);
        wlo = (unsigned long long)w0 | ((unsigned long long)w1 << 32); whi = (unsigned long long)w2 | ((unsigned long long)w3 << 32);
    }
    {
        att::Ref R{P + m0 * PW + C_NQ, P + (size_t)b * SEQ * PW + C_KS, P + (size_t)b * SEQ * PW + C_VS, PW, P0, SEQ, 0};
        att::Out E{Ob, scr, gf, 1};
        att::attn_pass<att::M_SEL, false>(R, F.ldsg, qr, E, mo, lo, wlo, whi);
    }
    {
        att::Ref R{P + m0 * PW + C_NQ, P + (size_t)b * SEQ * PW + C_KW, P + (size_t)b * SEQ * PW + C_VW, PW, P0, SEQ, 0};
        att::Out E{Ob, scr, gf, 2};
        att::attn_pass<att::M_WIN, false>(R, F.ldsg, qr, E, mo, lo, 0ull, 0ull);
    }
#if TOPK_CHECK
    __syncthreads(); if (F.MISC[20] != 0u && tid == 0) { asm volatile("s_waitcnt vmcnt(0)" ::: "memory"); Ob[0] = (bf16_t)0x7fc0; }
#endif
}
#ifndef EN_G4
#define EN_G4 1
#endif
#ifndef EN_G6
#define EN_G6 1
#endif
#ifndef EN_G7
#define EN_G7 1
#endif
#ifndef REV_DOWN
#define REV_DOWN 1
#endif
#ifndef REP_ATT
#define REP_ATT 1
#endif
#ifndef REP_G3
#define REP_G3 1
#endif
#ifndef REP_PRO
#define REP_PRO 1
#endif
#ifndef REP_NORM
#define REP_NORM 1
#endif
#ifndef REP_BAR
#define REP_BAR 1
#endif
#ifndef REP_PRE
#define REP_PRE 1
#endif
#ifndef REP_FOX
#define REP_FOX 1
#endif
#ifndef REP_NSA
#define REP_NSA 1
#endif
#ifndef REP_UP
#define REP_UP 1
#endif
#ifndef EN_PRO
#define EN_PRO 1
#endif
#ifndef EN_NORM
#define EN_NORM 1
#endif
#ifndef EN_PROJ
#define EN_PROJ 1
#endif
#ifndef EN_PRE
#define EN_PRE 1
#endif
#ifndef EN_ATT
#define EN_ATT 1
#endif
#ifndef EN_GEMM
#define EN_GEMM 1
#endif
#ifndef EN_FOX
#define EN_FOX 1
#endif
#ifndef EN_MOBA
#define EN_MOBA 1
#endif
#ifndef EN_NSA
#define EN_NSA 1
#endif

__global__ void __launch_bounds__(NWAVES * 64, 2) mega_fwd(Args args) {
    extern __shared__ __attribute__((aligned(16))) unsigned char lds[];
    Frame F;
    F.lds = (LAS unsigned char*)lds; F.ldsg = (char*)lds;
    F.MISC = (volatile LAS unsigned*)(F.lds + MISC_OFF);
    F.G = gridDim.x; { const int bx = blockIdx.x; F.vcu = (F.G % 8 == 0) ? (bx % 8) * (F.G / 8) + bx / 8 : bx; }
    F.ws = args.ws; F.ctl = (gu32*)(args.ws + WS_CTL); F.x = args.in[0]; F.out = args.out;
    for (int u = threadIdx.x; u < (LDS_BYTES - LDSCTL_OFF) / 4; u += NWAVES * 64) ((LAS unsigned*)(F.lds + LDSCTL_OFF))[u] = 0u;
    __syncthreads();
    XcdBarrier bar; bar.bar = (unsigned*)(F.ctl + CW_BAR); bar.x = 0; bar.st = nullptr;
    if (args.use_bar) bar = xcd_barrier_post((unsigned*)(F.ctl + CW_BAR), F.MISC + 8);
    const int lo = args.ph_lo, hi = args.ph_hi;
#define IN(k) (lo <= (k) && (k) < hi)
#define SEAM(k) do { if (IN(k) && IN((k) + 1)) { xcd_barrier(bar); if (REP_BAR > 1) xcd_barrier(bar); } } while (0)

    if (EN_PRO && IN(0)) { prologue_a(F, args); if (REP_PRO > 1) { __syncthreads(); prologue_a(F, args); } } SEAM(0);
    if (EN_PRO && IN(1)) { prologue_b(F, args); } SEAM(1);
    if (EN_NORM && IN(2)) { norm_phase<0>(F, 0); } SEAM(2);

    for (int l = 0; l < NL; ++l) {
        const int pb = N_PRO + PH_PER_LAYER * l;
#define WSF fresh(F.ws)
        if (EN_PROJ && IN(pb + 0)) { unsigned char* const wsl = fresh(F.ws); const int bid = fresh_s((int)blockIdx.x); (void)bid;
            pg8::Gemm g{(const bf16_t*)(wsl + WS_H), (const bf16_t*)(wsl + WS_WIN) + (size_t)l * NPROJ * DM, DM, DM, DM};
            pg8::StaticOrder S; S.init(MTOK, NPROJ, F.G, bid);
            pg8::EpiProj E{(bf16_t*)(wsl + WS_PROJ), (bf16_t*)(wsl + WS_KC), (bf16_t*)(wsl + WS_VC), (float*)(wsl + WS_GF), (const _Float16*)(wsl + WS_CS), args.in[10] + l * 8};
            S.rep = REP_G3; pg8::gemm_phase<pg8::EpiProj, pg8::StaticOrder, true, true>(F.lds, g, S, E);
        }
        SEAM(pb + 0);
        if (EN_PRE && IN(pb + 1)) { unsigned char* const wsl = fresh(F.ws); const int bid = fresh_s((int)blockIdx.x); (void)bid;
            for (int rep_ = 0; rep_ < REP_PRE; ++rep_) {
            if (bid < 128) {
                pg8::Gemm g{(const bf16_t*)(wsl + WS_KC), (const bf16_t*)(wsl + WS_W1T) + (size_t)l * 2 * 256 * 4096, 2048, 4096, 256};
                pg8::CmpOrder S{128, bid, WS_VC - WS_KC, (size_t)256 * 4096 * 2};
                pg8::EpiPart E{(float*)(wsl + WS_CPART)};
                pg8::gemm_phase<pg8::EpiPart, pg8::CmpOrder, false, true>(F.lds, g, S, E);
            }
            for (int it = (bid + 128) % F.G; it < 784; it += F.G) {
                if (it < 16) cumsum_item(F, it);
                else if (it < 272) kmean_item(F, it - 16);
                else foxnorm_item(F, it - 272);
            }
                    }
        }
        SEAM(pb + 1);
        if (EN_PRE && IN(pb + 2)) { unsigned char* const wsl = fresh(F.ws); const int bid = fresh_s((int)blockIdx.x); (void)bid; (void)wsl;
            for (int rep_ = 0; rep_ < REP_PRE; ++rep_) for (int it = bid; it < 256; it += F.G) cmp_stage2_item(F, args, l, it);
            for (int it = bid; it < 256; it += F.G) moba_gate_item(F, l, it);
        }
        SEAM(pb + 2);
        if (EN_ATT && IN(pb + 3)) { unsigned char* const wsl = fresh(F.ws); (void)wsl;
            gu32* head = F.ctl + CW_Q + 64 * l;
            for (;;) {
                __syncthreads();
                if (threadIdx.x == 0) F.MISC[16] = __hip_atomic_fetch_add(head, 1u, RLX_AGENT);
                __syncthreads();
                const int idx0 = __builtin_amdgcn_readfirstlane((int)F.MISC[16]);
                const int nconv = (l + 1 < NL) ? W_ITEMS_LAYER / 8 : 0;
                if (idx0 >= 1280 * REP_ATT + nconv) break;
                if (idx0 >= 1280 * REP_ATT) {
                    const int tid_ = fresh_tid(), wv_ = __builtin_amdgcn_readfirstlane(tid_ >> 6);
                    weight_item(fresh(F.ws), args, l + 1, (idx0 - 1280 * REP_ATT) * 8 + wv_, (LAS float*)(F.lds + wv_ * 16384), tid_ & 63);
                    continue;
                }
                const int idx = idx0 % 1280;
                if (idx < 1024) {
                    const int q = idx >> 5, s_ = idx & 31, qb = 31 - q;
                    if (s_ < 16) { if (EN_FOX) { fox_item(F, s_ >> 3, s_ & 7, qb); if (REP_FOX > 1) fox_item(F, s_ >> 3, s_ & 7, qb); } }
                    else if (s_ < 24) { if (EN_NSA) { nsa_item(F, (s_ - 16) >> 2, 4 * qb + 3 - ((s_ - 16) & 3)); if (REP_NSA > 1) nsa_item(F, (s_ - 16) >> 2, 4 * qb + 3 - ((s_ - 16) & 3)); } }
                    else if (q < 31) { if (EN_MOBA) moba_blk_item(F, l, s_ - 24, q, false); }
                } else { if (EN_MOBA) moba_blk_item(F, l, (idx - 1024) >> 5, (idx - 1024) & 31, true); }
            }
        }
        SEAM(pb + 3);
        if (EN_ATT && IN(pb + 4)) { moba_combine(F); }
        SEAM(pb + 4);
        if (EN_GEMM && EN_G4 && IN(pb + 5)) { unsigned char* const wsl = fresh(F.ws); const int bid = fresh_s((int)blockIdx.x); (void)bid;
            pg8::Gemm g{(const bf16_t*)(wsl + WS_O), (const bf16_t*)(wsl + WS_WOUT) + (size_t)l * DM * DM, DM, DM, DM};
            pg8::StaticOrder S; S.init(MTOK, DM, F.G, bid);
            pg8::EpiBf16<0> E{(bf16_t*)(wsl + WS_Y), DM};
            S.rep = REP_G3; pg8::gemm_phase<pg8::EpiBf16<0>, pg8::StaticOrder, true, true>(F.lds, g, S, E);
        }
        SEAM(pb + 5);
        if (EN_NORM && IN(pb + 6)) { unsigned char* const wsl = fresh(F.ws); const int bid = fresh_s((int)blockIdx.x); (void)bid; norm_phase<1>(F, l); }
        SEAM(pb + 6);
        if (EN_GEMM && EN_G6 && IN(pb + 7)) { unsigned char* const wsl = fresh(F.ws); const int bid = fresh_s((int)blockIdx.x); (void)bid;
            pg8::Gemm g{(const bf16_t*)(wsl + WS_H), (const bf16_t*)(wsl + WS_WUP) + (size_t)l * FF * DM, DM, DM, DM};
            pg8::StaticOrder S; S.init(MTOK, FF, F.G, bid);
            pg8::EpiBf16<1> E{(bf16_t*)(wsl + WS_U), FF};
            S.rep = REP_UP; pg8::gemm_phase<pg8::EpiBf16<1>, pg8::StaticOrder, true, true>(F.lds, g, S, E);
        }
        SEAM(pb + 7);
        if (EN_GEMM && EN_G7 && IN(pb + 8)) { unsigned char* const wsl = fresh(F.ws); const int bid = fresh_s((int)blockIdx.x); (void)bid;
            pg8::Gemm g{(const bf16_t*)(wsl + WS_U), (const bf16_t*)(wsl + WS_WDN) + (size_t)l * DM * FF, FF, FF, FF};
            pg8::StaticOrder S; S.init(MTOK, DM, F.G, bid, REV_DOWN);
            pg8::EpiBf16<0> E{(bf16_t*)(wsl + WS_Y), DM};
            S.rep = REP_G3; pg8::gemm_phase<pg8::EpiBf16<0>, pg8::StaticOrder, true, true>(F.lds, g, S, E);
        }
        SEAM(pb + 8);
        if (EN_NORM && IN(pb + 9)) { unsigned char* const wsl = fresh(F.ws); const int bid = fresh_s((int)blockIdx.x); (void)bid; norm_phase<2>(F, l); }
        if (l + 1 < NL) SEAM(pb + 9);
    }
#undef IN
#undef SEAM
}

extern "C" void kernel_launch(void* const* d_in, const int* in_sizes, int n_in, void* d_out, int out_size, void* d_ws, size_t ws_size, hipStream_t stream) {
    static int grid = 0;
    if (grid == 0) {
        if (n_in != 20 || out_size != MTOK * DM || ws_size < WS_END) { fprintf(stderr, "kernel_launch: unexpected shapes (n_in %d, out %d, ws %zu, need %zu)\n", n_in, out_size, ws_size, (size_t)WS_END); grid = -1; return; }
        int dev = 0, cus = 0, per_cu = 0;
        if (hipGetDevice(&dev) != hipSuccess || hipDeviceGetAttribute(&cus, hipDeviceAttributeMultiprocessorCount, dev) != hipSuccess) { grid = -1; return; }
        if (hipFuncSetAttribute((const void*)mega_fwd, hipFuncAttributeMaxDynamicSharedMemorySize, LDS_BYTES) != hipSuccess) { fprintf(stderr, "kernel_launch: hipFuncSetAttribute failed\n"); grid = -1; return; }
        if (hipOccupancyMaxActiveBlocksPerMultiprocessor(&per_cu, (const void*)mega_fwd, NWAVES * 64, LDS_BYTES) != hipSuccess || per_cu < 1)
            fprintf(stderr, "kernel_launch: occupancy query reports %d workgroups per CU\n", per_cu);
        (void)hipGetLastError();
        grid = cus < 256 ? cus : 256;
        if (grid != 256) fprintf(stderr, "kernel_launch: %d CUs; this kernel is laid out for 256\n", grid);
    }
    if (grid < 0) return;
    (void)hipMemsetAsync((char*)d_ws + WS_CTL, 0, CTL_ZERO_BYTES, stream);
    Args a{};
    for (int i = 0; i < 20; ++i) a.in[i] = (const float*)d_in[i];
    a.out = (float*)d_out; a.ws = (unsigned char*)d_ws; a.pad = 0;
#if MK_SINGLE
    a.ph_lo = 0; a.ph_hi = N_PHASES; a.use_bar = 1;
    hipLaunchKernelGGL(mega_fwd, dim3(grid), dim3(NWAVES * 64), LDS_BYTES, stream, a);
#else
    for (int p = 0; p < N_PHASES; ++p) { a.ph_lo = p; a.ph_hi = p + 1; a.use_bar = 0;
        hipLaunchKernelGGL(mega_fwd, dim3(grid), dim3(NWAVES * 64), LDS_BYTES, stream, a); }
#endif
}
```
